# Optimizing an MI355X kernel written in HIP

```python
import jax, jax.numpy as jnp
from jax import lax
import numpy as np

D_MODEL = 2048
BATCH = 4
SEQ = 4096
DEPTH = 2

GRID_W = 64
CTX_LEN = 256
N_MIXERS = 2
N_MLA_LAYERS = (DEPTH + 1) // 2
N_NA_LAYERS = DEPTH // 2
MLA_HEADS = 16
MLA_Q_RANK = 512
MLA_KV_RANK = 512
MLA_NOPE = 128
MLA_ROPE = 64
MLA_V = 128
NA_HEADS = 16
NA_HEAD_DIM = D_MODEL // NA_HEADS
NA_WIN_R = 8
NA_WIN_C = 16
D_FF = -(-(8 * D_MODEL) // (3 * 256)) * 256
ROPE_THETA = 10000.0
EPS = 1e-6
Q_BLOCK = 128

kernel_name = "hybrid_mla_natten_dit_block"


def rmsnorm(x, g):
    x32 = x.astype(jnp.float32)
    y = x32 * lax.rsqrt(jnp.mean(x32 * x32, axis=-1, keepdims=True) + EPS)
    return (y * g.astype(jnp.float32)).astype(x.dtype)


def modulate(h, shift, scale):
    return h * (1 + scale) + shift


def swiglu(h, w_gate, w_up, w_down):
    return (jax.nn.silu(h @ w_gate) * (h @ w_up)) @ w_down


def attention(q, k, v, scale):
    s = jnp.einsum('bqhd,bkhd->bhqk', q, k) * scale
    p = jax.nn.softmax(s.astype(jnp.float32), axis=-1).astype(v.dtype)
    return jnp.einsum('bhqk,bkhd->bqhd', p, v)


def blocked_attention(q, k, v, scale):
    B, S, H, Dq = q.shape
    nb = S // Q_BLOCK
    qb = q.reshape(B, nb, Q_BLOCK, H, Dq).transpose(1, 0, 2, 3, 4)
    ob = lax.map(lambda qi: attention(qi, k, v, scale), qb)
    return ob.transpose(1, 0, 2, 3, 4).reshape(B, S, H, v.shape[-1])


def axial_rope_tables(S, dtype):
    t = jnp.arange(S)
    row = (t // GRID_W).astype(jnp.float32)
    col = (t % GRID_W).astype(jnp.float32)
    n_freq = MLA_ROPE // 4
    inv_freq = ROPE_THETA ** (-jnp.arange(n_freq, dtype=jnp.float32) / n_freq)
    ang_r = row[:, None] * inv_freq
    ang_c = col[:, None] * inv_freq
    return (jnp.cos(ang_r)[:, None, :].astype(dtype), jnp.sin(ang_r)[:, None, :].astype(dtype),
            jnp.cos(ang_c)[:, None, :].astype(dtype), jnp.sin(ang_c)[:, None, :].astype(dtype))


def rope_1d(x, cos, sin):
    x1, x2 = jnp.split(x, 2, axis=-1)
    return jnp.concatenate([x1 * cos - x2 * sin, x2 * cos + x1 * sin], axis=-1)


def rope_2d(x, rope):
    cos_r, sin_r, cos_c, sin_c = rope
    xr, xc = jnp.split(x, 2, axis=-1)
    return jnp.concatenate([rope_1d(xr, cos_r, sin_r), rope_1d(xc, cos_c, sin_c)], axis=-1)


def _mla_q(t, w_dq, q_norm, w_uq):
    B, L, _ = t.shape
    cq = rmsnorm(t @ w_dq, q_norm)
    q = (cq @ w_uq).reshape(B, L, MLA_HEADS, MLA_NOPE + MLA_ROPE)
    return q[..., :MLA_NOPE], q[..., MLA_NOPE:]


def _mla_kv(t, w_dkv, kv_norm, w_ukv):
    B, L, _ = t.shape
    kv_a = t @ w_dkv
    c_kv = rmsnorm(kv_a[..., :MLA_KV_RANK], kv_norm)
    k_pe = kv_a[..., MLA_KV_RANK:][:, :, None, :]
    kv = (c_kv @ w_ukv).reshape(B, L, MLA_HEADS, MLA_NOPE + MLA_V)
    return kv[..., :MLA_NOPE], k_pe, kv[..., MLA_NOPE:]


def _assemble(nope, pe):
    pe = jnp.broadcast_to(pe, nope.shape[:-1] + (pe.shape[-1],))
    return jnp.concatenate([nope, pe], axis=-1)


def mla_mixer(h, hc, w_dq, q_norm, w_uq, w_dkv, kv_norm, w_ukv, w_o, rope, with_ctx_out):
    B, S, _ = h.shape
    Lc = hc.shape[1]
    scale = (MLA_NOPE + MLA_ROPE) ** -0.5
    q_nope, q_pe = _mla_q(h, w_dq, q_norm, w_uq)
    k_nope, k_pe, v = _mla_kv(h, w_dkv, kv_norm, w_ukv)
    q = _assemble(q_nope, rope_2d(q_pe, rope))
    k = _assemble(k_nope, rope_2d(k_pe, rope))
    kc_nope, kc_pe, vc = _mla_kv(hc, w_dkv, kv_norm, w_ukv)
    kc = _assemble(kc_nope, kc_pe)
    keys = jnp.concatenate([kc, k], axis=1)
    vals = jnp.concatenate([vc, v], axis=1)
    y = blocked_attention(q, keys, vals, scale).reshape(B, S, MLA_HEADS * MLA_V) @ w_o
    yc = None
    if with_ctx_out:
        qc_nope, qc_pe = _mla_q(hc, w_dq, q_norm, w_uq)
        qc = _assemble(qc_nope, qc_pe)
        yc = attention(qc, kc, vc, scale).reshape(B, Lc, MLA_HEADS * MLA_V) @ w_o
    return y, yc


def na_mixer(h, hc, w_qkv, rel_bias, w_o, with_ctx_out):
    B, S, _ = h.shape
    Lc = hc.shape[1]
    rows = S // GRID_W
    kr = min(NA_WIN_R, rows)
    HD = NA_HEADS * NA_HEAD_DIM
    scale = NA_HEAD_DIM ** -0.5
    qkv = (h @ w_qkv).reshape(B, rows, GRID_W, 3, NA_HEADS, NA_HEAD_DIM)
    q_g, k_g, v_g = qkv[..., 0, :, :], qkv[..., 1, :, :], qkv[..., 2, :, :]
    kvc = (hc @ w_qkv[:, HD:]).reshape(B, Lc, 2, NA_HEADS, NA_HEAD_DIM)
    kc, vc = kvc[:, :, 0], kvc[:, :, 1]
    col = jnp.arange(GRID_W)
    col_start = jnp.clip(col - NA_WIN_C // 2, 0, GRID_W - NA_WIN_C)
    col_idx = col_start[:, None] + jnp.arange(NA_WIN_C)[None, :]
    dc = col_idx - col[:, None] + (NA_WIN_C - 1)
    bias_c = rel_bias[:, :, dc]
    n_loc = kr * NA_WIN_C

    def row_block(r):
        rs = jnp.clip(r - kr // 2, 0, rows - kr)
        q_r = lax.dynamic_index_in_dim(q_g, r, axis=1, keepdims=False)
        k_rows = lax.dynamic_slice_in_dim(k_g, rs, kr, axis=1)
        v_rows = lax.dynamic_slice_in_dim(v_g, rs, kr, axis=1)
        k_win = k_rows[:, :, col_idx]
        v_win = v_rows[:, :, col_idx]
        dr = rs + jnp.arange(kr) - r + (NA_WIN_R - 1)
        bias = bias_c[:, dr].transpose(0, 2, 1, 3)
        s_loc = jnp.einsum('bqhd,biqjhd->bhqij', q_r, k_win) * scale + bias[None]
        s_loc = s_loc.reshape(B, NA_HEADS, GRID_W, n_loc)
        s_ctx = jnp.einsum('bqhd,bkhd->bhqk', q_r, kc) * scale
        p = jax.nn.softmax(jnp.concatenate([s_loc, s_ctx], axis=-1).astype(jnp.float32), axis=-1).astype(v_g.dtype)
        p_loc = p[..., :n_loc].reshape(B, NA_HEADS, GRID_W, kr, NA_WIN_C)
        return (jnp.einsum('bhqij,biqjhd->bqhd', p_loc, v_win)
                + jnp.einsum('bhqk,bkhd->bqhd', p[..., n_loc:], vc))

    o = lax.map(row_block, jnp.arange(rows))
    y = o.transpose(1, 0, 2, 3, 4).reshape(B, S, HD) @ w_o
    yc = None
    if with_ctx_out:
        qc = (hc @ w_qkv[:, :HD]).reshape(B, Lc, NA_HEADS, NA_HEAD_DIM)
        yc = attention(qc, kc, vc, scale).reshape(B, Lc, HD) @ w_o
    return y, yc


def setup_inputs(seed: int = 0) -> dict:
    key = jax.random.key(seed)
    ks = jax.random.split(key, 24)
    f32 = jnp.float32
    D = D_MODEL

    def w(k, shape, fan_in, g=1.0):
        return jax.random.normal(k, shape, f32) * (g * fan_in ** -0.5)

    def gain(k, shape):
        return 1.0 + 0.05 * jax.random.normal(k, shape, f32)

    return {
        "x": jax.random.normal(ks[0], (BATCH, SEQ, D), f32),
        "c": jax.random.normal(ks[1], (BATCH, D), f32),
        "ctx": jax.random.normal(ks[2], (BATCH, CTX_LEN, D), f32),
        "c_ctx": jax.random.normal(ks[3], (D,), f32),
        "ada_w": w(ks[4], (DEPTH, D, 6 * D), D, 0.3),
        "ada_b": 0.02 * jax.random.normal(ks[5], (DEPTH, 6 * D), f32),
        "norm_mix": gain(ks[6], (DEPTH, D)),
        "norm_ffn": gain(ks[7], (DEPTH, D)),
        "norm_final": gain(ks[8], (D,)),
        "mla_w_dq": w(ks[9], (N_MLA_LAYERS, D, MLA_Q_RANK), D),
        "mla_q_norm": gain(ks[10], (N_MLA_LAYERS, MLA_Q_RANK)),
        "mla_w_uq": w(ks[11], (N_MLA_LAYERS, MLA_Q_RANK, MLA_HEADS * (MLA_NOPE + MLA_ROPE)), MLA_Q_RANK),
        "mla_w_dkv": w(ks[12], (N_MLA_LAYERS, D, MLA_KV_RANK + MLA_ROPE), D),
        "mla_kv_norm": gain(ks[13], (N_MLA_LAYERS, MLA_KV_RANK)),
        "mla_w_ukv": w(ks[14], (N_MLA_LAYERS, MLA_KV_RANK, MLA_HEADS * (MLA_NOPE + MLA_V)), MLA_KV_RANK),
        "mla_w_o": w(ks[15], (N_MLA_LAYERS, MLA_HEADS * MLA_V, D), MLA_HEADS * MLA_V),
        "na_w_qkv": w(ks[16], (N_NA_LAYERS, D, 3 * NA_HEADS * NA_HEAD_DIM), D),
        "na_rel_bias": 0.1 * jax.random.normal(ks[17], (N_NA_LAYERS, NA_HEADS, 2 * NA_WIN_R - 1, 2 * NA_WIN_C - 1), f32),
        "na_w_o": w(ks[18], (N_NA_LAYERS, NA_HEADS * NA_HEAD_DIM, D), NA_HEADS * NA_HEAD_DIM),
        "ffn_w_gate": w(ks[19], (DEPTH, D, D_FF), D),
        "ffn_w_up": w(ks[20], (DEPTH, D, D_FF), D),
        "ffn_w_down": w(ks[21], (DEPTH, D_FF, D), D_FF),
    }


def reference(x, c, ctx, c_ctx, ada_w, ada_b, norm_mix, norm_ffn, norm_final,
              mla_w_dq, mla_q_norm, mla_w_uq, mla_w_dkv, mla_kv_norm, mla_w_ukv, mla_w_o,
              na_w_qkv, na_rel_bias, na_w_o,
              ffn_w_gate, ffn_w_up, ffn_w_down):
    S = x.shape[1]
    rope = axial_rope_tables(S, x.dtype)
    xc = ctx
    for i in range(DEPTH):
        last = i == DEPTH - 1
        j = i // N_MIXERS
        m = jax.nn.silu(c) @ ada_w[i] + ada_b[i]
        mc = jax.nn.silu(c_ctx) @ ada_w[i] + ada_b[i]
        sh1, sc1, g1, sh2, sc2, g2 = jnp.split(m[:, None, :], 6, axis=-1)
        csh1, csc1, cg1, csh2, csc2, cg2 = jnp.split(mc, 6, axis=-1)
        h = modulate(rmsnorm(x, norm_mix[i]), sh1, sc1)
        hc = modulate(rmsnorm(xc, norm_mix[i]), csh1, csc1)
        if i % N_MIXERS == 0:
            y, yc = mla_mixer(h, hc, mla_w_dq[j], mla_q_norm[j], mla_w_uq[j], mla_w_dkv[j],
                              mla_kv_norm[j], mla_w_ukv[j], mla_w_o[j], rope, not last)
        else:
            y, yc = na_mixer(h, hc, na_w_qkv[j], na_rel_bias[j], na_w_o[j], not last)
        x = x + g1 * y
        x = x + g2 * swiglu(modulate(rmsnorm(x, norm_ffn[i]), sh2, sc2),
                            ffn_w_gate[i], ffn_w_up[i], ffn_w_down[i])
        if not last:
            xc = xc + cg1 * yc
            xc = xc + cg2 * swiglu(modulate(rmsnorm(xc, norm_ffn[i]), csh2, csc2),
                                   ffn_w_gate[i], ffn_w_up[i], ffn_w_down[i])
    return rmsnorm(x, norm_final)
```

```cpp
#define MK_ONE_LAUNCH 1
#include <hip/hip_runtime.h>
namespace pg8 {
#define PG8_LAS __attribute__((address_space(3)))
typedef unsigned short bf16_t;
typedef short bf16x8 __attribute__((ext_vector_type(8)));
typedef float f32x4 __attribute__((ext_vector_type(4)));
typedef unsigned u32x4 __attribute__((ext_vector_type(4)));
constexpr int BM = 256, BK = 64, HALF = 128, HTB = HALF * BK * 2  , STAGE_BYTES = 8 * HTB, NXCD = 8, WGM = 8;

__host__ __device__ __forceinline__ int lds_byte(int r, int c) { const int st = (r >> 4) * 2 + (c >> 5), rr = r & 15, cc = c & 31, ob = rr * 64 + cc * 2; return st * 1024 + (ob ^ (((ob >> 9) & 1) << 5)); }
__host__ __device__ __forceinline__ void stage_rc(int b, int& R, int& C) { const int st = b / 1024, sb = b % 1024, swz = sb ^ (((sb >> 9) & 1) << 5); R = (st >> 1) * 16 + swz / 64; C = (st & 1) * 32 + (swz % 64) / 2; }
__host__ __device__ __forceinline__ int perm32(int rho) { const int n = rho >> 4, i = rho & 15; return 8 * (i >> 2) + 4 * n + (i & 3); }

struct Unit { int pm, pn; };
struct Gemm { const bf16_t* A; const bf16_t* Bt; int M, N, K; };

struct StaticOrder {
    int nM, nN, nwg, G, c;
    __host__ __device__ void init(int M, int N, int G_, int c_) { nM = M / BM; nN = N / BM; nwg = nM * nN; G = G_; c = c_; }
    __host__ __device__ bool next(int i, Unit& u) const {
        const long L = (long)i * G + c; if (L >= nwg) return false;
        int wgid = (int)L; { const int q = nwg / NXCD, r = nwg % NXCD, xcd = wgid % NXCD, off = wgid / NXCD; wgid = (xcd < r ? xcd * (q + 1) : r * (q + 1) + (xcd - r) * q) + off; }
        const int nig = WGM * nN, gid = wgid / nig, fm = gid * WGM, gsz = (nM - fm) < WGM ? (nM - fm) : WGM;
        u.pm = fm + ((wgid % nig) % gsz); u.pn = (wgid % nig) / gsz; return true;
    }
    __device__ __forceinline__ void a_ready(const Unit&) const {}
    __device__ __forceinline__ void done(const Unit&) const {}
};
struct CountedOrder : StaticOrder {
    const unsigned* ready; unsigned need; unsigned* tmo;
    __device__ __forceinline__ void a_ready(const Unit& u) const {
        if (threadIdx.x < 64) {
            const unsigned long long t0 = __builtin_amdgcn_s_memrealtime(); unsigned polls = 0;
            while ((unsigned)__builtin_amdgcn_readfirstlane(__hip_atomic_load(ready + 64 * u.pm, __ATOMIC_RELAXED, __HIP_MEMORY_SCOPE_AGENT)) < need) {
                if ((++polls & 255u) == 0u && __builtin_amdgcn_readfirstlane(__hip_atomic_load(tmo, __ATOMIC_RELAXED, __HIP_MEMORY_SCOPE_AGENT)) != 0u) break;
                if (__builtin_amdgcn_s_memrealtime() - t0 > 2000000ull) {
                    if (threadIdx.x == 0) { unsigned expect = 0u; __hip_atomic_compare_exchange_strong(tmo + 1, &expect, 0x600u | (unsigned)(u.pm & 0xff), __ATOMIC_RELAXED, __ATOMIC_RELAXED, __HIP_MEMORY_SCOPE_AGENT); __hip_atomic_store(tmo, 1u, __ATOMIC_RELAXED, __HIP_MEMORY_SCOPE_AGENT); }
                    break; }
                __builtin_amdgcn_s_sleep(2); }
            __builtin_amdgcn_fence(__ATOMIC_ACQUIRE, "agent");
            asm volatile("s_waitcnt vmcnt(0)" ::: "memory");
        }
#if !defined(BROKEN_HOOK_NO_BARRIER)
        asm volatile("" ::: "memory"); __builtin_amdgcn_s_barrier(); asm volatile("" ::: "memory");
#endif
    }
};

__device__ __forceinline__ unsigned cvt_pk_bf16(float lo, float hi) { unsigned r; asm volatile("v_cvt_pk_bf16_f32 %0, %1, %2" : "=v"(r) : "v"(lo), "v"(hi)); return r; }
typedef float f32x2 __attribute__((ext_vector_type(2)));
__device__ __forceinline__ f32x2 gelu_pk(f32x2 v) {
    const f32x2 av = __builtin_elementwise_abs(v), d = av * 0.2316418882f + 1.0f;
    f32x2 t; t.x = __builtin_amdgcn_rcpf(d.x); t.y = __builtin_amdgcn_rcpf(d.y);
    f32x2 q = t * 0.5307027145f + (-0.7265760135f); q = q * t + 0.7107068705f; q = q * t + (-0.142248368f); q = q * t + 0.127414796f; q = q * t;
    const f32x2 s = (v * v) * (-0.72134752044f);
    f32x2 e; e.x = __builtin_amdgcn_exp2f(s.x); e.y = __builtin_amdgcn_exp2f(s.y);
    const f32x2 m = v * (q * e), r = v - m;
    f32x2 o; o.x = v.x < 0.f ? m.x : r.x; o.y = v.y < 0.f ? m.y : r.y; return o;
}

struct EpiF32 {
    static constexpr bool PERM = false, AFTER_DRAIN = false;
    float* C; int ldc; const float* bias;
    __device__ __forceinline__ void operator()(const f32x4 (&acc)[2][2][4][2], const Unit& u, int wr, int wc, int fr, int fq) const {
        const int row0 = u.pm * BM + wr * 64 + fr, col0 = u.pn * BM + wc * 32 + 4 * fq;
        f32x4 bv[2][2];
#pragma unroll
        for (int bj = 0; bj < 2; ++bj)
#pragma unroll
            for (int n = 0; n < 2; ++n) bv[bj][n] = bias ? *(const f32x4*)(bias + col0 + bj * HALF + n * 16) : (f32x4){0.f, 0.f, 0.f, 0.f};
#pragma unroll
        for (int ai = 0; ai < 2; ++ai)
#pragma unroll
            for (int m = 0; m < 4; ++m) { float* rowp = C + (size_t)(row0 + ai * HALF + m * 16) * ldc + col0;
#pragma unroll
                for (int bj = 0; bj < 2; ++bj)
#pragma unroll
                    for (int n = 0; n < 2; ++n) *(f32x4*)(rowp + bj * HALF + n * 16) = acc[ai][bj][m][n] + bv[bj][n]; }
    }
};
template <int ACT  > struct EpiBf16 {
    static constexpr bool PERM = true, AFTER_DRAIN = false;
    bf16_t* O; int ldc; const float* bias; int split_cols; size_t split_stride;
    __device__ __forceinline__ void operator()(const f32x4 (&acc)[2][2][4][2], const Unit& u, int wr, int wc, int fr, int fq) const {
        const int row0 = u.pm * BM + wr * 64 + fr; int colt = u.pn * BM; bf16_t* base = O;
        if (split_cols) { const int t = colt / split_cols; base += (size_t)t * split_stride; colt -= t * split_cols; }
        const int col0 = colt + wc * 32 + 8 * fq, bcol0 = u.pn * BM + wc * 32 + 8 * fq;
        f32x4 bv[2][2];
#pragma unroll
        for (int bj = 0; bj < 2; ++bj)
#pragma unroll
            for (int n = 0; n < 2; ++n) bv[bj][n] = bias ? *(const f32x4*)(bias + bcol0 + bj * HALF + 4 * n) : (f32x4){0.f, 0.f, 0.f, 0.f};
#pragma unroll
        for (int ai = 0; ai < 2; ++ai)
#pragma unroll
            for (int m = 0; m < 4; ++m) { bf16_t* rowp = base + (size_t)(row0 + ai * HALF + m * 16) * ldc + col0;
#pragma unroll
                for (int bj = 0; bj < 2; ++bj) { f32x4 v0 = acc[ai][bj][m][0] + bv[bj][0], v1 = acc[ai][bj][m][1] + bv[bj][1];
                    if (ACT == 1) { f32x2 a = gelu_pk((f32x2){v0[0], v0[1]}), b = gelu_pk((f32x2){v0[2], v0[3]}), c = gelu_pk((f32x2){v1[0], v1[1]}), d = gelu_pk((f32x2){v1[2], v1[3]});
                        v0 = (f32x4){a.x, a.y, b.x, b.y}; v1 = (f32x4){c.x, c.y, d.x, d.y}; }
                    if (ACT == 2) {
#pragma unroll
                        for (int j = 0; j < 4; ++j) { v0[j] = 0.5f * v0[j] * (1.0f + erff(v0[j] * 0.70710678f)); v1[j] = 0.5f * v1[j] * (1.0f + erff(v1[j] * 0.70710678f)); } }
                    u32x4 w; w.x = cvt_pk_bf16(v0[0], v0[1]); w.y = cvt_pk_bf16(v0[2], v0[3]); w.z = cvt_pk_bf16(v1[0], v1[1]); w.w = cvt_pk_bf16(v1[2], v1[3]);
                    *(u32x4*)(rowp + bj * HALF) = w; } }
    }
};

template <class Epi, class Sched, bool STAMP = false>
__device__ __forceinline__ void gemm_phase(PG8_LAS unsigned char* lds, const Gemm g, const Sched& S, const Epi& E, unsigned long long* stamps) {
    const int tid = threadIdx.x, wid = __builtin_amdgcn_readfirstlane(tid >> 6), lane = tid & 63, wr = wid >> 2, wc = wid & 3, fr = lane & 15, fq = lane >> 4;
    const int K = g.K, nt = K / BK;
    int ts_lo = 0, ts_hi = 0, nts = 0; const unsigned long long rt_entry = STAMP ? (unsigned long long)wall_clock64() : 0ull;
#define PG8_STAMP() do { if (STAMP && wid == 0 && nts < 64) { const unsigned long long _c = (unsigned long long)clock64(); \
        ts_lo = (lane == nts) ? (int)(unsigned)_c : ts_lo; ts_hi = (lane == nts) ? (int)(unsigned)(_c >> 32) : ts_hi; ++nts; } } while (0)
    PG8_STAMP();
    unsigned voffA[2], voffB[2];
#pragma unroll
    for (int i = 0; i < 2; ++i) { int R, C; stage_rc(tid * 16 + i * 8192, R, C); const int Rb = Epi::PERM ? ((R & ~31) + perm32(R & 31)) : R;
        voffA[i] = (unsigned)(R * K + C) * 2u; voffB[i] = (unsigned)(Rb * K + C) * 2u; }
    const size_t kstep = (size_t)(BK * 2);
    const size_t hstep = (size_t)HALF * K * 2;
    const size_t tstep = 2 * hstep;
    const unsigned ldsw = (unsigned)wid * 1024u;
    const int aoff = lds_byte(wr * 64 + fr, fq * 8), boff = lds_byte(wc * 32 + fr, fq * 8);
#define PG8_SA(b, h) (((b) * 2 + (h)) * HTB)
#define PG8_SB(b, h) ((4 + (b) * 2 + (h)) * HTB)
#define PG8_STAGE(bufoff, gbase, voff) do { _Pragma("unroll") for (int _i = 0; _i < 2; ++_i) \
        __builtin_amdgcn_global_load_lds((const unsigned*)((const char*)(gbase) + (voff)[_i]), (PG8_LAS unsigned*)(lds + (bufoff) + ldsw + _i * 8192), 16, 0, 0); } while (0)
#define PG8_LDA(dst, b, h) do { _Pragma("unroll") for (int m = 0; m < 4; ++m) _Pragma("unroll") for (int k = 0; k < 2; ++k) dst[m][k] = *(const PG8_LAS bf16x8*)(lds + PG8_SA(b, h) + aoff + m * 2048 + k * 1024); } while (0)
#define PG8_LDB(dst, b, h) do { _Pragma("unroll") for (int n = 0; n < 2; ++n) _Pragma("unroll") for (int k = 0; k < 2; ++k) dst[n][k] = *(const PG8_LAS bf16x8*)(lds + PG8_SB(b, h) + boff + n * 2048 + k * 1024); } while (0)
#define PG8_MMA(ai, bj, At, Bt) do { __builtin_amdgcn_s_setprio(1); _Pragma("unroll") for (int m = 0; m < 4; ++m) _Pragma("unroll") for (int n = 0; n < 2; ++n) _Pragma("unroll") for (int k = 0; k < 2; ++k) \
        acc[ai][bj][m][n] = __builtin_amdgcn_mfma_f32_16x16x32_bf16(Bt[n][k], At[m][k], acc[ai][bj][m][n], 0, 0, 0); __builtin_amdgcn_s_setprio(0); } while (0)
#define PG8_WAIT_V(n) asm volatile("s_waitcnt vmcnt(" #n ")" ::: "memory")
#define PG8_WAIT_L(n) asm volatile("s_waitcnt lgkmcnt(" #n ")" ::: "memory")
#define PG8_BAR __builtin_amdgcn_s_barrier()
#define PG8_SCHED __builtin_amdgcn_sched_barrier(0)
    Unit cur, nxt; int ui = 0;
    if (!S.next(0, cur)) return;
    f32x4 acc[2][2][4][2];
#pragma unroll
    for (int a = 0; a < 2; ++a)
#pragma unroll
        for (int b = 0; b < 2; ++b)
#pragma unroll
            for (int m = 0; m < 4; ++m)
#pragma unroll
                for (int n = 0; n < 2; ++n) acc[a][b][m][n] = (f32x4){0.f, 0.f, 0.f, 0.f};
    bf16x8 At[4][2], B0[2][2], B1[2][2];
    const char* cA = (const char*)g.A + (size_t)cur.pm * tstep; const char* cB = (const char*)g.Bt + (size_t)cur.pn * tstep;
    S.a_ready(cur);
    PG8_STAGE(PG8_SB(0, 0), cB, voffB); PG8_STAGE(PG8_SA(0, 0), cA, voffA); PG8_STAGE(PG8_SB(0, 1), cB + hstep, voffB); PG8_STAGE(PG8_SA(0, 1), cA + hstep, voffA);
    if (wr == 1) PG8_BAR;
    PG8_WAIT_V(4); PG8_BAR;
    PG8_STAGE(PG8_SB(1, 0), cB + kstep, voffB); PG8_STAGE(PG8_SA(1, 0), cA + kstep, voffA); PG8_STAGE(PG8_SB(1, 1), cB + hstep + kstep, voffB);
    PG8_WAIT_V(6); PG8_BAR;
    PG8_STAMP();
    for (;;) {
        const bool has_next = S.next(ui + 1, nxt);
        const char* nA = has_next ? (const char*)g.A + (size_t)nxt.pm * tstep : cA; const char* nB = has_next ? (const char*)g.Bt + (size_t)nxt.pn * tstep : cB;
        for (int t = 0; t < nt; t += 2) {
            const bool last = (t == nt - 2);
            const char* a1 = cA + (size_t)(t + 1) * kstep;
            const char* a2 = last ? nA : cA + (size_t)(t + 2) * kstep; const char* b2 = last ? nB : cB + (size_t)(t + 2) * kstep;
            const char* a3 = a2 + kstep; const char* b3 = b2 + kstep;
            if (last && has_next) S.a_ready(nxt);
            PG8_LDB(B0, 0, 0); PG8_SCHED; PG8_LDA(At, 0, 0); PG8_STAGE(PG8_SA(1, 1), a1 + hstep, voffA);
            PG8_WAIT_L(8); PG8_BAR; PG8_WAIT_L(0); PG8_MMA(0, 0, At, B0); PG8_BAR; PG8_SCHED;
            PG8_LDB(B1, 0, 1); PG8_STAGE(PG8_SB(0, 0), b2, voffB);
            PG8_BAR; PG8_WAIT_L(0); PG8_MMA(0, 1, At, B1); PG8_BAR;
            PG8_LDA(At, 0, 1); PG8_STAGE(PG8_SA(0, 0), a2, voffA);
            PG8_BAR; PG8_WAIT_L(0); PG8_MMA(1, 0, At, B0); PG8_BAR; PG8_SCHED;
            PG8_STAGE(PG8_SB(0, 1), b2 + hstep, voffB);
            PG8_WAIT_V(6); PG8_BAR; PG8_MMA(1, 1, At, B1); PG8_BAR;
            PG8_LDB(B0, 1, 0); PG8_SCHED; PG8_LDA(At, 1, 0); PG8_STAGE(PG8_SA(0, 1), a2 + hstep, voffA);
            PG8_WAIT_L(8); PG8_BAR; PG8_WAIT_L(0); PG8_MMA(0, 0, At, B0); PG8_BAR; PG8_SCHED;
            PG8_LDB(B1, 1, 1); PG8_STAGE(PG8_SB(1, 0), b3, voffB);
            PG8_BAR; PG8_WAIT_L(0); PG8_MMA(0, 1, At, B1); PG8_BAR;
            PG8_LDA(At, 1, 1); PG8_STAGE(PG8_SA(1, 0), a3, voffA);
            PG8_BAR; PG8_WAIT_L(0); PG8_MMA(1, 0, At, B0); PG8_BAR; PG8_SCHED;
            PG8_STAGE(PG8_SB(1, 1), b3 + hstep, voffB);
            PG8_WAIT_V(6); PG8_BAR; PG8_MMA(1, 1, At, B1); PG8_BAR;
        }
        PG8_STAMP();
        if constexpr (!Epi::AFTER_DRAIN) { E(acc, cur, wr, wc, fr, fq); S.done(cur); }
        PG8_STAMP();
        if (!has_next) break;
#pragma unroll
        for (int a = 0; a < 2; ++a)
#pragma unroll
            for (int b = 0; b < 2; ++b)
#pragma unroll
                for (int m = 0; m < 4; ++m)
#pragma unroll
                    for (int n = 0; n < 2; ++n) acc[a][b][m][n] = (f32x4){0.f, 0.f, 0.f, 0.f};
        cur = nxt; cA = nA; cB = nB; ++ui;
    }
    PG8_WAIT_V(0);
    if (wr == 0) PG8_BAR;
    PG8_BAR;
    if constexpr (Epi::AFTER_DRAIN) { E.fused(acc, cur, wr, wc, fr, fq, lds, wid, lane); S.done(cur); }
    PG8_STAMP();
    if (STAMP && wid == 0) { stamps[lane] = lane < nts ? (((unsigned long long)(unsigned)ts_hi << 32) | (unsigned)ts_lo) : 0ull;
        if (lane == 62) stamps[62] = rt_entry; if (lane == 63) stamps[63] = (unsigned long long)wall_clock64(); }
#undef PG8_STAMP
#undef PG8_SA
#undef PG8_SB
#undef PG8_STAGE
#undef PG8_LDA
#undef PG8_LDB
#undef PG8_MMA
#undef PG8_WAIT_V
#undef PG8_WAIT_L
#undef PG8_BAR
#undef PG8_SCHED
}
}


#include <hip/hip_cooperative_groups.h>
#include <cstdio>
namespace cg = cooperative_groups;

#ifndef MK_ONE_LAUNCH
#define MK_ONE_LAUNCH 1
#endif

#define LAS __attribute__((address_space(3)))
typedef unsigned short bf16_t;
typedef short bf16x8 __attribute__((ext_vector_type(8)));
typedef short s16x4 __attribute__((ext_vector_type(4)));
typedef float f32x4 __attribute__((ext_vector_type(4)));
typedef float f32x2 __attribute__((ext_vector_type(2)));
typedef float f32x8 __attribute__((ext_vector_type(8)));
typedef float f32x16 __attribute__((ext_vector_type(16)));
typedef unsigned u32x4 __attribute__((ext_vector_type(4)));
typedef unsigned u32x2 __attribute__((ext_vector_type(2)));

constexpr int DM = 2048, NBATCH = 4, SEQ = 4096, CTXL = 256, TB = SEQ + CTXL  , TROWS = NBATCH * TB  ;
constexpr int NH = 16, DFF = 5632, NA_ = 1280  , NQ = 3072, NKV = 4096, NQKV = 6144, NGU = 2 * DFF;
constexpr int NWAVES = 8, NTHREADS = 512;
constexpr float EPS = 1e-6f;

constexpr size_t al256(size_t x) { return (x + 255) / 256 * 256; }
constexpr size_t WS_WA = 0;
constexpr size_t WS_WUQ = WS_WA + al256((size_t)NA_ * DM * 2);
constexpr size_t WS_WUKV = WS_WUQ + al256((size_t)NQ * 512 * 2);
constexpr size_t WS_WO0 = WS_WUKV + al256((size_t)NKV * 512 * 2);
constexpr size_t WS_WQKV = WS_WO0 + al256((size_t)DM * DM * 2);
constexpr size_t WS_WO1 = WS_WQKV + al256((size_t)NQKV * DM * 2);
constexpr size_t WS_WGU0 = WS_WO1 + al256((size_t)DM * DM * 2);
constexpr size_t WS_WGU1 = WS_WGU0 + al256((size_t)NGU * DM * 2);
constexpr size_t WS_WD0 = WS_WGU1 + al256((size_t)NGU * DM * 2);
constexpr size_t WS_WD1 = WS_WD0 + al256((size_t)DM * DFF * 2);
constexpr size_t WS_MOD = WS_WD1 + al256((size_t)DM * DFF * 2);
constexpr size_t WS_ROPE = WS_MOD + al256((size_t)2 * 5 * 6 * DM * 4);
constexpr size_t WS_XC = WS_ROPE + al256(64 * 16 * 8);
constexpr size_t WS_H = WS_XC + al256((size_t)NBATCH * CTXL * DM * 4);
constexpr size_t WS_Q = WS_H + al256((size_t)TROWS * DM * 2);
constexpr size_t WS_KV = WS_Q + al256((size_t)TROWS * NQ * 2);
constexpr size_t WS_ACT = WS_KV + al256((size_t)TROWS * NKV * 2);
constexpr size_t WS_QA = WS_ACT;
constexpr size_t WS_CQ = WS_QA + al256((size_t)TROWS * NA_ * 4);
constexpr size_t WS_CKV = WS_CQ + al256((size_t)TROWS * 512 * 2);
constexpr size_t WS_KPE = WS_CKV + al256((size_t)TROWS * 512 * 2);
constexpr size_t WS_END = WS_ACT + al256((size_t)TROWS * DFF * 2);
static_assert(WS_KPE + (size_t)TROWS * 64 * 2 <= WS_END, "alias region");
static_assert((size_t)TROWS * NQKV * 2 <= WS_ACT - WS_Q, "qkv alias");

constexpr int LDS_BYTES = 131072 + 4096;

struct Params {
    const float *x, *c, *ctx, *c_ctx, *ada_w, *ada_b, *norm_mix, *norm_ffn, *norm_final;
    const float *w_dq, *q_norm, *w_uq, *w_dkv, *kv_norm, *w_ukv, *mla_wo, *na_wqkv, *na_bias, *na_wo, *w_gate, *w_up, *w_down;
    float* out; unsigned char* ws;
    int ph_lo, ph_hi;
};

struct Frame { int tid, lane, wave, G, vcu; };

__device__ __forceinline__ unsigned pk2(float lo, float hi) { unsigned r; asm volatile("v_cvt_pk_bf16_f32 %0, %1, %2" : "=v"(r) : "v"(lo), "v"(hi)); return r; }
__device__ __forceinline__ float wave_sum(float v) {
#pragma unroll
    for (int o = 1; o < 64; o <<= 1) v += __shfl_xor(v, o);
    return v;
}
__device__ __forceinline__ float silu_f(float v) { return v / (1.0f + __expf(-v)); }
__device__ __forceinline__ int rope_perm(int d) { return d < 16 ? 2 * d : d < 32 ? 2 * (d - 16) + 1 : d < 48 ? 2 * (d - 16) : 2 * (d - 32) + 1; }

template <int KIND> __device__ __forceinline__ int dst_row(int n) {
    if (KIND == 0) return n;
    if (KIND == 1) return n < 512 ? 512 + n : 1024 + rope_perm(n - 512);
    if (KIND == 2) { const int h = n / 192, d = n - h * 192; return h * 192 + (d < 128 ? d : 128 + rope_perm(d - 128)); }
    if (KIND == 3) return (n >> 7) * 256 + (n & 127);
    return (n >> 7) * 256 + 128 + (n & 127);
}
template <int KIND>
__device__ __forceinline__ void transpose_item(const float* __restrict__ W, int K, int N, bf16_t* __restrict__ WT, LAS float* scr, int item, int lane) {
    const int nblk = N / 32, kb = item / nblk, nb = item - kb * nblk, k0 = 64 * kb, n0 = 32 * nb;
#pragma unroll 8
    for (int i = 0; i < 32; ++i) { const int kk = 2 * i + (lane >> 5); scr[kk * 33 + (lane & 31)] = W[(size_t)(k0 + kk) * N + n0 + (lane & 31)]; }
    asm volatile("s_waitcnt lgkmcnt(0)" ::: "memory");
    const int c = lane & 7;
#pragma unroll
    for (int j = 0; j < 4; ++j) { const int n = (lane >> 3) + 8 * j; const LAS float* s = scr + (8 * c) * 33 + n;
        u32x4 o; o.x = pk2(s[0 * 33], s[1 * 33]); o.y = pk2(s[2 * 33], s[3 * 33]); o.z = pk2(s[4 * 33], s[5 * 33]); o.w = pk2(s[6 * 33], s[7 * 33]);
        *(u32x4*)(WT + (size_t)dst_row<KIND>(n0 + n) * K + k0 + 8 * c) = o; }
    asm volatile("s_waitcnt lgkmcnt(0)" ::: "memory");
}

__device__ __forceinline__ void phase0(const Params& p, const Frame& F, LAS unsigned char* lds) {
    unsigned char* ws = p.ws;
    { const int gt = blockIdx.x * NTHREADS + F.tid;
      if (gt < 64 * 16) { const int pos = gt >> 4, f = gt & 15; const float inv = powf(10000.0f, -(float)f / 16.0f); const float ang = (float)pos * inv;
          const double a = (double)ang; const double n = rint(a * 0.15915494309189535); const float r = (float)(a - n * 6.283185307179586);
          ((f32x2*)(ws + WS_ROPE))[gt] = (f32x2){__cosf(r), __sinf(r)}; } }
    { bf16_t* wa = (bf16_t*)(ws + WS_WA) + (size_t)1088 * DM; const int n16 = 192 * DM / 8;
      for (int i = blockIdx.x * NTHREADS + F.tid; i < n16; i += F.G * NTHREADS) ((u32x4*)wa)[i] = (u32x4){0u, 0u, 0u, 0u}; }
    if ((int)blockIdx.x < 192) {
        LAS float* sc = (LAS float*)lds;
        LAS float* red = (LAS float*)(lds + 5 * 2048 * 4);
        for (int i = F.tid; i < 5 * 2048; i += NTHREADS) { const int r = i >> 11, k = i & 2047; const float v = r < 4 ? p.c[r * DM + k] : p.c_ctx[k]; sc[i] = silu_f(v); }
        __syncthreads();
        const int item = blockIdx.x, l = item / 96, nb = item % 96, n = nb * 128 + F.lane * 2;
        const float* W = p.ada_w + (size_t)l * DM * (6 * DM) + n;
        float a0[5] = {0.f, 0.f, 0.f, 0.f, 0.f}, a1[5] = {0.f, 0.f, 0.f, 0.f, 0.f};
        const int kbeg = F.wave * 256;
        for (int k = kbeg; k < kbeg + 256; k += 8) {
            f32x2 w[8];
#pragma unroll
            for (int u = 0; u < 8; ++u) w[u] = *(const f32x2*)(W + (size_t)(k + u) * (6 * DM));
#pragma unroll
            for (int r = 0; r < 5; ++r) {
                const f32x4 s0 = *(const LAS f32x4*)(sc + r * 2048 + k), s1 = *(const LAS f32x4*)(sc + r * 2048 + k + 4);
                a0[r] += s0.x * w[0].x + s0.y * w[1].x + s0.z * w[2].x + s0.w * w[3].x + s1.x * w[4].x + s1.y * w[5].x + s1.z * w[6].x + s1.w * w[7].x;
                a1[r] += s0.x * w[0].y + s0.y * w[1].y + s0.z * w[2].y + s0.w * w[3].y + s1.x * w[4].y + s1.y * w[5].y + s1.z * w[6].y + s1.w * w[7].y;
            }
        }
#pragma unroll
        for (int r = 0; r < 5; ++r) { red[(F.wave * 5 + r) * 128 + F.lane * 2] = a0[r]; red[(F.wave * 5 + r) * 128 + F.lane * 2 + 1] = a1[r]; }
        __syncthreads();
        for (int i = F.tid; i < 5 * 128; i += NTHREADS) { const int r = i >> 7, cc = i & 127; float s = 0.f;
#pragma unroll
            for (int w = 0; w < 8; ++w) s += red[(w * 5 + r) * 128 + cc];
            const int nn = nb * 128 + cc; ((float*)(ws + WS_MOD))[(size_t)(l * 5 + r) * (6 * DM) + nn] = s + p.ada_b[l * 6 * DM + nn]; }
        __syncthreads();
    }
    LAS float* scr = (LAS float*)(lds + F.wave * 16384);
    const int gw = F.vcu * NWAVES + F.wave, NGW = F.G * NWAVES;
    constexpr int I0 = 32 * 16, I1 = 32 * 18, I2 = 8 * 96, I3 = 8 * 128, I4 = 32 * 64, I5 = 32 * 192, I6 = 32 * 64, IG = 32 * 176, ID = 88 * 64;
    constexpr int NITEMS = I0 + I1 + I2 + I3 + I4 + I5 + I6 + 4 * IG + 2 * ID;
    for (int it = gw; it < NITEMS; it += NGW) {
        int r = it;
        if (r < I0) { transpose_item<0>(p.w_dq, DM, 512, (bf16_t*)(ws + WS_WA), scr, r, F.lane); continue; } r -= I0;
        if (r < I1) { transpose_item<1>(p.w_dkv, DM, 576, (bf16_t*)(ws + WS_WA), scr, r, F.lane); continue; } r -= I1;
        if (r < I2) { transpose_item<2>(p.w_uq, 512, NQ, (bf16_t*)(ws + WS_WUQ), scr, r, F.lane); continue; } r -= I2;
        if (r < I3) { transpose_item<0>(p.w_ukv, 512, NKV, (bf16_t*)(ws + WS_WUKV), scr, r, F.lane); continue; } r -= I3;
        if (r < I4) { transpose_item<0>(p.mla_wo, DM, DM, (bf16_t*)(ws + WS_WO0), scr, r, F.lane); continue; } r -= I4;
        if (r < I5) { transpose_item<0>(p.na_wqkv, DM, NQKV, (bf16_t*)(ws + WS_WQKV), scr, r, F.lane); continue; } r -= I5;
        if (r < I6) { transpose_item<0>(p.na_wo, DM, DM, (bf16_t*)(ws + WS_WO1), scr, r, F.lane); continue; } r -= I6;
        if (r < IG) { transpose_item<3>(p.w_gate, DM, DFF, (bf16_t*)(ws + WS_WGU0), scr, r, F.lane); continue; } r -= IG;
        if (r < IG) { transpose_item<4>(p.w_up, DM, DFF, (bf16_t*)(ws + WS_WGU0), scr, r, F.lane); continue; } r -= IG;
        if (r < IG) { transpose_item<3>(p.w_gate + (size_t)DM * DFF, DM, DFF, (bf16_t*)(ws + WS_WGU1), scr, r, F.lane); continue; } r -= IG;
        if (r < IG) { transpose_item<4>(p.w_up + (size_t)DM * DFF, DM, DFF, (bf16_t*)(ws + WS_WGU1), scr, r, F.lane); continue; } r -= IG;
        if (r < ID) { transpose_item<0>(p.w_down, DFF, DM, (bf16_t*)(ws + WS_WD0), scr, r, F.lane); continue; } r -= ID;
        transpose_item<0>(p.w_down + (size_t)DFF * DM, DFF, DM, (bf16_t*)(ws + WS_WD1), scr, r, F.lane);
    }
}

template <bool FROM_INPUT>
__device__ __forceinline__ void phase_norm(const Params& p, const Frame& F, int layer, int which, bool skip_ctx) {
    const int gw = F.vcu * NWAVES + F.wave, NGW = F.G * NWAVES;
    const float* gn = (which ? p.norm_ffn : p.norm_mix) + layer * DM;
    const float* mod = (const float*)(p.ws + WS_MOD) + (size_t)layer * 5 * 6 * DM;
    bf16_t* Hb = (bf16_t*)(p.ws + WS_H);
    for (int row = gw; row < TROWS; row += NGW) {
        const int b = row / TB, rb = row - b * TB; const bool isctx = rb < CTXL;
        if (isctx && skip_ctx) continue;
        const float* src;
        if (FROM_INPUT) src = isctx ? p.ctx + (size_t)(b * CTXL + rb) * DM : p.x + (size_t)(b * SEQ + rb - CTXL) * DM;
        else src = isctx ? (const float*)(p.ws + WS_XC) + (size_t)(b * CTXL + rb) * DM : p.out + (size_t)(b * SEQ + rb - CTXL) * DM;
        const float* mr = mod + (size_t)(isctx ? 4 : b) * 6 * DM + (which ? 3 : 0) * DM;
        f32x4 v[8]; float ss = 0.f;
#pragma unroll
        for (int j = 0; j < 8; ++j) { v[j] = *(const f32x4*)(src + 4 * F.lane + 256 * j); ss += (v[j].x * v[j].x + v[j].y * v[j].y) + (v[j].z * v[j].z + v[j].w * v[j].w); }
        const float rstd = rsqrtf(wave_sum(ss) * (1.0f / DM) + EPS);
#pragma unroll
        for (int j = 0; j < 8; ++j) { const int c = 4 * F.lane + 256 * j;
            const f32x4 g = *(const f32x4*)(gn + c), sh = *(const f32x4*)(mr + c), sc = *(const f32x4*)(mr + DM + c);
            const f32x4 y = (v[j] * rstd * g) * (sc + 1.0f) + sh;
            u32x2 o; o.x = pk2(y.x, y.y); o.y = pk2(y.z, y.w);
            *(u32x2*)(Hb + (size_t)row * DM + c) = o; }
    }
}

__device__ __forceinline__ void phase_mla_norm(const Params& p, const Frame& F) {
    const int gw = F.vcu * NWAVES + F.wave, NGW = F.G * NWAVES;
    const float* QA = (const float*)(p.ws + WS_QA);
    bf16_t* CQ = (bf16_t*)(p.ws + WS_CQ); bf16_t* CKV = (bf16_t*)(p.ws + WS_CKV); bf16_t* KPE = (bf16_t*)(p.ws + WS_KPE);
    const f32x2* rope = (const f32x2*)(p.ws + WS_ROPE);
    for (int row = gw; row < TROWS; row += NGW) {
        const int b = row / TB, rb = row - b * TB; const bool isctx = rb < CTXL;
        const float* src = QA + (size_t)row * NA_;
        const f32x4 q0 = *(const f32x4*)(src + 8 * F.lane), q1 = *(const f32x4*)(src + 8 * F.lane + 4);
        const f32x4 k0 = *(const f32x4*)(src + 512 + 8 * F.lane), k1 = *(const f32x4*)(src + 512 + 8 * F.lane + 4);
        const float pe = src[1024 + F.lane];
        float sq = (q0.x * q0.x + q0.y * q0.y) + (q0.z * q0.z + q0.w * q0.w) + (q1.x * q1.x + q1.y * q1.y) + (q1.z * q1.z + q1.w * q1.w);
        float sk = (k0.x * k0.x + k0.y * k0.y) + (k0.z * k0.z + k0.w * k0.w) + (k1.x * k1.x + k1.y * k1.y) + (k1.z * k1.z + k1.w * k1.w);
        const float rq = rsqrtf(wave_sum(sq) * (1.0f / 512.0f) + EPS), rk = rsqrtf(wave_sum(sk) * (1.0f / 512.0f) + EPS);
        const f32x4 gq0 = *(const f32x4*)(p.q_norm + 8 * F.lane), gq1 = *(const f32x4*)(p.q_norm + 8 * F.lane + 4);
        const f32x4 gk0 = *(const f32x4*)(p.kv_norm + 8 * F.lane), gk1 = *(const f32x4*)(p.kv_norm + 8 * F.lane + 4);
        const f32x4 a0 = q0 * rq * gq0, a1 = q1 * rq * gq1, c0 = k0 * rk * gk0, c1 = k1 * rk * gk1;
        u32x4 o; o.x = pk2(a0.x, a0.y); o.y = pk2(a0.z, a0.w); o.z = pk2(a1.x, a1.y); o.w = pk2(a1.z, a1.w);
        *(u32x4*)(CQ + (size_t)row * 512 + 8 * F.lane) = o;
        o.x = pk2(c0.x, c0.y); o.y = pk2(c0.z, c0.w); o.z = pk2(c1.x, c1.y); o.w = pk2(c1.z, c1.w);
        *(u32x4*)(CKV + (size_t)row * 512 + 8 * F.lane) = o;
        const float other = __shfl_xor(pe, 1);
        float r = pe;
        if (!isctx) { const int s = rb - CTXL, gr = s >> 6, gc = s & 63; const int i = F.lane >> 1, f = i & 15; const int pos = i < 16 ? gr : gc;
            const f32x2 cs = rope[pos * 16 + f];
            r = (F.lane & 1) ? pe * cs.x + other * cs.y : pe * cs.x - other * cs.y; }
        const float rn = __shfl_xor(r, 1);
        if (!(F.lane & 1)) *(unsigned*)(KPE + (size_t)row * 64 + F.lane) = pk2(r, rn);
    }
}

__device__ __forceinline__ void phase_final(const Params& p, const Frame& F) {
    const int gw = F.vcu * NWAVES + F.wave, NGW = F.G * NWAVES;
    for (int row = gw; row < NBATCH * SEQ; row += NGW) {
        float* src = p.out + (size_t)row * DM;
        f32x4 v[8]; float ss = 0.f;
#pragma unroll
        for (int j = 0; j < 8; ++j) { v[j] = *(const f32x4*)(src + 4 * F.lane + 256 * j); ss += (v[j].x * v[j].x + v[j].y * v[j].y) + (v[j].z * v[j].z + v[j].w * v[j].w); }
        const float rstd = rsqrtf(wave_sum(ss) * (1.0f / DM) + EPS);
#pragma unroll
        for (int j = 0; j < 8; ++j) { const int c = 4 * F.lane + 256 * j; const f32x4 g = *(const f32x4*)(p.norm_final + c); *(f32x4*)(src + c) = v[j] * rstd * g; }
    }
}

using pg8::Unit; using pg8::HALF; using pg8::BM;
struct EpiQ {
    static constexpr bool PERM = true, AFTER_DRAIN = false;
    bf16_t* O; const f32x2* rope;
    __device__ __forceinline__ void operator()(const f32x4 (&acc)[2][2][4][2], const Unit& u, int wr, int wc, int fr, int fq) const {
        const int b = u.pm / 17, j = u.pm - b * 17; const bool latent = j > 0;
#pragma unroll
        for (int bj = 0; bj < 2; ++bj) {
            const int c32 = u.pn * BM + bj * HALF + wc * 32; const int hd = c32 / 192, off = c32 - hd * 192; const bool isrope = (off >= 128) && latent; const bool colrope = off == 160;
#pragma unroll
            for (int ai = 0; ai < 2; ++ai)
#pragma unroll
                for (int m = 0; m < 4; ++m) {
                    const int row = u.pm * BM + ai * HALF + wr * 64 + m * 16 + fr;
                    f32x4 v0 = acc[ai][bj][m][0], v1 = acc[ai][bj][m][1];
                    if (isrope) { const int gr = 4 * (j - 1) + 2 * ai + wr, gc = 16 * m + fr; const int pos = colrope ? gc : gr;
                        const f32x4 t0 = *(const f32x4*)(rope + pos * 16 + 4 * fq), t1 = *(const f32x4*)(rope + pos * 16 + 4 * fq + 2);
                        f32x4 w0, w1;
                        w0.x = v0.x * t0.x - v0.y * t0.y; w0.y = v0.y * t0.x + v0.x * t0.y; w0.z = v0.z * t0.z - v0.w * t0.w; w0.w = v0.w * t0.z + v0.z * t0.w;
                        w1.x = v1.x * t1.x - v1.y * t1.y; w1.y = v1.y * t1.x + v1.x * t1.y; w1.z = v1.z * t1.z - v1.w * t1.w; w1.w = v1.w * t1.z + v1.z * t1.w;
                        v0 = w0; v1 = w1; }
                    u32x4 w; w.x = pk2(v0[0], v0[1]); w.y = pk2(v0[2], v0[3]); w.z = pk2(v1[0], v1[1]); w.w = pk2(v1[2], v1[3]);
                    *(u32x4*)(O + (size_t)row * NQ + c32 + 8 * fq) = w; }
        }
    }
};
struct EpiRes {
    static constexpr bool PERM = false, AFTER_DRAIN = false;
    const float *src_lat, *src_ctx; float *dst_lat, *dst_ctx; const float* gate;
    __device__ __forceinline__ void operator()(const f32x4 (&acc)[2][2][4][2], const Unit& u, int wr, int wc, int fr, int fq) const {
        const int b = u.pm / 17, j = u.pm - b * 17; const bool isctx = j == 0;
        const size_t rbase = isctx ? (size_t)b * CTXL : (size_t)b * SEQ + (size_t)(j - 1) * 256;
        const float* sp = (isctx ? src_ctx : src_lat) + rbase * DM; float* dp = (isctx ? dst_ctx : dst_lat) + rbase * DM;
        const float* g = gate + (size_t)(isctx ? 4 : b) * 6 * DM;
        const int col0 = u.pn * BM + wc * 32 + 4 * fq;
        f32x4 gv[2][2];
#pragma unroll
        for (int bj = 0; bj < 2; ++bj)
#pragma unroll
            for (int n = 0; n < 2; ++n) gv[bj][n] = *(const f32x4*)(g + col0 + bj * HALF + n * 16);
#pragma unroll
        for (int ai = 0; ai < 2; ++ai)
#pragma unroll
            for (int m = 0; m < 4; ++m) { const size_t off = (size_t)(ai * HALF + wr * 64 + m * 16 + fr) * DM + col0;
#pragma unroll
                for (int bj = 0; bj < 2; ++bj)
#pragma unroll
                    for (int n = 0; n < 2; ++n) { const f32x4 r = *(const f32x4*)(sp + off + bj * HALF + n * 16); *(f32x4*)(dp + off + bj * HALF + n * 16) = r + gv[bj][n] * acc[ai][bj][m][n]; }
                asm volatile("" ::: "memory"); }
    }
};
struct EpiSwiglu {
    static constexpr bool PERM = true, AFTER_DRAIN = false;
    bf16_t* O;
    __device__ __forceinline__ void operator()(const f32x4 (&acc)[2][2][4][2], const Unit& u, int wr, int wc, int fr, int fq) const {
        const int col0 = u.pn * HALF + wc * 32 + 8 * fq;
#pragma unroll
        for (int ai = 0; ai < 2; ++ai)
#pragma unroll
            for (int m = 0; m < 4; ++m) { const int row = u.pm * BM + ai * HALF + wr * 64 + m * 16 + fr;
                f32x4 r0, r1;
#pragma unroll
                for (int e = 0; e < 4; ++e) { const float g0 = acc[ai][0][m][0][e], g1 = acc[ai][0][m][1][e];
                    r0[e] = g0 * __builtin_amdgcn_rcpf(1.0f + __expf(-g0)) * acc[ai][1][m][0][e]; r1[e] = g1 * __builtin_amdgcn_rcpf(1.0f + __expf(-g1)) * acc[ai][1][m][1][e]; }
                u32x4 w; w.x = pk2(r0[0], r0[1]); w.y = pk2(r0[2], r0[3]); w.z = pk2(r1[0], r1[1]); w.w = pk2(r1[2], r1[3]);
                *(u32x4*)(O + (size_t)row * DFF + col0) = w; }
    }
};
struct LatentOrder : pg8::StaticOrder {
    __device__ bool next(int i, Unit& u) const { if (!pg8::StaticOrder::next(i, u)) return false; u.pm = u.pm + (u.pm >> 4) + 1; return true; }
};

namespace att {
#define SBAR() __builtin_amdgcn_sched_barrier(0)
constexpr int QBLK = 32, KVBLK = 64, DV = 128;
constexpr float THR = 8.f;
template <int DQK> struct Sc { static constexpr float SCALE = DQK == 192 ? 0.07216878364870322f : 0.08838834764831845f; };
__device__ __forceinline__ int crow(int r, int hi) { return (r & 3) + 8 * (r >> 2) + 4 * hi; }
template <int DQK> __device__ __forceinline__ int kswz(int row, int colB) { return row * (DQK * 2) + (colB ^ ((row & 7) << 4)); }

template <int DQK>
__device__ __forceinline__ void partialSM(f32x16& p0, f32x16& p1, float& m_reg, float& mn, float& alpha) {
    constexpr float SCALE = Sc<DQK>::SCALE; constexpr float C = SCALE * 1.4426950408889634f;
    float pmax = p0[0];
#pragma unroll
    for (int r = 1; r < 16; ++r) pmax = fmaxf(pmax, p0[r]);
#pragma unroll
    for (int r = 0; r < 16; ++r) pmax = fmaxf(pmax, p1[r]);
    { auto rr = __builtin_amdgcn_permlane32_swap(__float_as_uint(pmax), __float_as_uint(pmax), false, false);
      pmax = fmaxf(__uint_as_float(rr[0]), __uint_as_float(rr[1])); }
    if (__builtin_expect(__all(pmax - m_reg <= THR / SCALE), 1)) { mn = m_reg; alpha = 1.f; }
    else { mn = fmaxf(m_reg, pmax); alpha = __builtin_amdgcn_exp2f((m_reg - mn) * C); m_reg = mn; }
    const float mnC = -mn * C;
#pragma unroll
    for (int r = 0; r < 16; ++r) p0[r] = fmaf(p0[r], C, mnC);
#pragma unroll
    for (int r = 0; r < 16; ++r) p1[r] = fmaf(p1[r], C, mnC);
#pragma unroll
    for (int r = 0; r < 16; ++r) p0[r] = __builtin_amdgcn_exp2f(p0[r]);
}
__device__ __forceinline__ void finishSM(f32x16& p0, f32x16& p1, float alpha, float& l_reg, bf16x8& pa0, bf16x8& pa1, bf16x8& pa2, bf16x8& pa3) {
#pragma unroll
    for (int r = 0; r < 16; ++r) p1[r] = __builtin_amdgcn_exp2f(p1[r]);
    float ps = 0;
#pragma unroll
    for (int r = 0; r < 16; ++r) ps += p0[r];
#pragma unroll
    for (int r = 0; r < 16; ++r) ps += p1[r];
    { auto rr = __builtin_amdgcn_permlane32_swap(__float_as_uint(ps), __float_as_uint(ps), false, false);
      ps = __uint_as_float(rr[0]) + __uint_as_float(rr[1]); }
    l_reg = l_reg * alpha + ps;
#define PK4(P, BASE, OUT) do { unsigned a0 = pk2(P[BASE + 0], P[BASE + 1]), a1 = pk2(P[BASE + 2], P[BASE + 3]);   \
    unsigned b0 = pk2(P[BASE + 4], P[BASE + 5]), b1 = pk2(P[BASE + 6], P[BASE + 7]);                              \
    auto r0 = __builtin_amdgcn_permlane32_swap(a0, b0, false, false); auto r1 = __builtin_amdgcn_permlane32_swap(a1, b1, false, false); \
    u32x4 w = {r0[0], r1[0], r0[1], r1[1]}; OUT = *reinterpret_cast<bf16x8*>(&w); } while (0)
    PK4(p0, 0, pa0); PK4(p0, 8, pa1); PK4(p1, 0, pa2); PK4(p1, 8, pa3);
#undef PK4
}
template <int DQK>
__device__ __forceinline__ void qkt(f32x16& p0, f32x16& p1, const char* Ks, const bf16x8* qr, int r32, int hi) {
    p0 = f32x16{}; p1 = f32x16{};
#pragma unroll
    for (int d0 = 0; d0 < DQK / 16; ++d0) { const int cb = (d0 * 16 + hi * 8) * 2;
        const bf16x8 b0 = *reinterpret_cast<const bf16x8*>(Ks + kswz<DQK>(r32, cb));
        const bf16x8 b1 = *reinterpret_cast<const bf16x8*>(Ks + kswz<DQK>(32 + r32, cb));
        p0 = __builtin_amdgcn_mfma_f32_32x32x16_bf16(b0, qr[d0], p0, 0, 0, 0);
        p1 = __builtin_amdgcn_mfma_f32_32x32x16_bf16(b1, qr[d0], p1, 0, 0, 0); }
}
__device__ __forceinline__ int v_st(int k, int c) { const int kk = (k & ~0xC) | ((k & 4) << 1) | ((k & 8) >> 1); return ((kk >> 3) * 4 + (c >> 5)) * 512 + ((kk & 7) * 32 + (c & 31)) * 2; }
__device__ __forceinline__ int v_rd_base(int lane) { return ((lane & 3) << 3) | (((lane >> 2) & 3) << 6) | (((lane >> 4) & 1) << 5) | (((lane >> 5) & 1) << 8); }
constexpr int v_rd_off(int d0, int ks, int half) { return d0 * 512 + ks * 4096 + half * 2048; }
template <int OFF> __device__ __forceinline__ s16x4 tr_read(int vb) {
    s16x4 r; asm volatile("ds_read_b64_tr_b16 %0, %1 offset:%2" : "=&v"(r) : "v"(vb), "i"(OFF) : "memory"); return r;
}
template <int D0> __device__ __forceinline__ void pv_one(f32x16& od, int vb, bf16x8 pa0, bf16x8 pa1, bf16x8 pa2, bf16x8 pa3) {
    const s16x4 l0 = tr_read<v_rd_off(D0, 0, 0)>(vb), h0 = tr_read<v_rd_off(D0, 0, 1)>(vb), l1 = tr_read<v_rd_off(D0, 1, 0)>(vb), h1 = tr_read<v_rd_off(D0, 1, 1)>(vb);
    const s16x4 l2 = tr_read<v_rd_off(D0, 2, 0)>(vb), h2 = tr_read<v_rd_off(D0, 2, 1)>(vb), l3 = tr_read<v_rd_off(D0, 3, 0)>(vb), h3 = tr_read<v_rd_off(D0, 3, 1)>(vb);
    asm volatile("s_waitcnt lgkmcnt(0)" ::: "memory"); SBAR();
#define PK(L, H) (bf16x8){L[0], L[1], L[2], L[3], H[0], H[1], H[2], H[3]}
    od = __builtin_amdgcn_mfma_f32_32x32x16_bf16(pa0, PK(l0, h0), od, 0, 0, 0);
    od = __builtin_amdgcn_mfma_f32_32x32x16_bf16(pa1, PK(l1, h1), od, 0, 0, 0);
    od = __builtin_amdgcn_mfma_f32_32x32x16_bf16(pa2, PK(l2, h2), od, 0, 0, 0);
    od = __builtin_amdgcn_mfma_f32_32x32x16_bf16(pa3, PK(l3, h3), od, 0, 0, 0);
#undef PK
}
__device__ __forceinline__ void pv_d0(f32x16* o, int vb, bf16x8 pa0, bf16x8 pa1, bf16x8 pa2, bf16x8 pa3) {
    pv_one<0>(o[0], vb, pa0, pa1, pa2, pa3); pv_one<1>(o[1], vb, pa0, pa1, pa2, pa3); pv_one<2>(o[2], vb, pa0, pa1, pa2, pa3); pv_one<3>(o[3], vb, pa0, pa1, pa2, pa3);
}
struct NoMod { __device__ __forceinline__ void operator()(f32x16&, f32x16&, int, int, int, int) const {} };
struct NaMod {
    const float* btab;
    int r0, lo;
    __device__ __forceinline__ void operator()(f32x16& p0, f32x16& p1, int t, int wid, int r32, int hi) const {
        if (t < 4) return;
        const int kr = lo + t - 4, r = r0 + (wid >> 1); const int rs = min(max(r - 4, 0), 56); const bool vrow = kr >= rs && kr < rs + 8;
        const int c = (wid & 1) * 32 + r32, cs = min(max(c - 8, 0), 48); const int dr = vrow ? kr - r + 7 : 0;
        const float* bt = btab + dr * 31 + 15 - c;
#pragma unroll
        for (int g = 0; g < 16; ++g) { const int kc0 = crow(g, hi), kc1 = 32 + kc0;
            const bool ok0 = vrow && kc0 >= cs && kc0 < cs + 16, ok1 = vrow && kc1 >= cs && kc1 < cs + 16;
            const float b0 = bt[ok0 ? kc0 : c - 15], b1 = bt[ok1 ? kc1 : c - 15];
            p0[g] = ok0 ? p0[g] + b0 : -1e30f; p1[g] = ok1 ? p1[g] + b1 : -1e30f; }
    }
};

template <int DQK> struct Lds { static constexpr int SHM_V = KVBLK * DV * 2, SHM_K = KVBLK * DQK * 2, WS_OFF = 2 * SHM_V + 2 * SHM_K, BT_OFF = WS_OFF + 8 * 64 * 4, TOTAL = BT_OFF + 2048; };

template <int DQK, int LDQ, int LDK, int LDV, int LDO, int SDEPTH, class Mod>
__device__ __forceinline__ void attn_body(const bf16_t* __restrict__ Qb, const bf16_t* __restrict__ Kn, const bf16_t* __restrict__ Kp, const bf16_t* __restrict__ Vh,
                                          bf16_t* __restrict__ Ob, int NT, int loff, const Mod& mod, char* lds) {
    constexpr int SHM_V = Lds<DQK>::SHM_V, SHM_K = Lds<DQK>::SHM_K; constexpr bool PE = DQK == 192;
    const int tid = threadIdx.x, wid = tid >> 6, lane = tid & 63, r32 = lane & 31, hi = lane >> 5;
    char* V_lds = lds; char* K_lds = lds + 2 * SHM_V;
    float* wsl = (float*)(lds + Lds<DQK>::WS_OFF) + wid * 64; float* li_l = wsl; float* al_l = wsl + 32;
    float m_reg = -1e30f, l_reg = 0; f32x16 o[4] = {}; bf16x8 qr[DQK / 16];
    const bf16_t* Qw = Qb + (long)(wid * QBLK + r32) * LDQ + hi * 8;
#pragma unroll
    for (int d0 = 0; d0 < DQK / 16; ++d0) qr[d0] = *reinterpret_cast<const bf16x8*>(Qw + d0 * 16);
    const int sr = tid >> 4, sc = (tid & 15) * 8, vst0 = v_st(sr, sc), vst1 = v_st(32 + sr, sc);
    const int pr = tid >> 3, pc = (tid & 7) * 8;
    const int vb0 = (int)(uintptr_t)V_lds + v_rd_base(lane);
    struct { bf16x8 vs0, vs1, ks0, ks1, kp; } sr_[SDEPTH];
#define KROW(t) ((t) * KVBLK + ((t) >= 4 ? loff : 0))
#define SLOAD(i, t) do { const long k0_ = KROW(t); sr_[i].vs0 = *reinterpret_cast<const bf16x8*>(&Vh[(k0_ + sr) * LDV + sc]); sr_[i].vs1 = *reinterpret_cast<const bf16x8*>(&Vh[(k0_ + 32 + sr) * LDV + sc]); \
    sr_[i].ks0 = *reinterpret_cast<const bf16x8*>(&Kn[(k0_ + sr) * LDK + sc]); sr_[i].ks1 = *reinterpret_cast<const bf16x8*>(&Kn[(k0_ + 32 + sr) * LDK + sc]); \
    if constexpr (PE) sr_[i].kp = *reinterpret_cast<const bf16x8*>(&Kp[(k0_ + pr) * 64 + pc]); } while (0)
#define SWRITE(b, i) do { *(bf16x8*)(V_lds + (b) * SHM_V + vst0) = sr_[i].vs0; *(bf16x8*)(V_lds + (b) * SHM_V + vst1) = sr_[i].vs1; const int kc = sc * 2; \
    *(bf16x8*)(K_lds + (b) * SHM_K + kswz<DQK>(sr, kc)) = sr_[i].ks0; *(bf16x8*)(K_lds + (b) * SHM_K + kswz<DQK>(32 + sr, kc)) = sr_[i].ks1; \
    if constexpr (PE) *(bf16x8*)(K_lds + (b) * SHM_K + kswz<DQK>(pr, 256 + pc * 2)) = sr_[i].kp; } while (0)
#define SWAIT() do { if constexpr (SDEPTH == 2) { if constexpr (PE) asm volatile("s_waitcnt vmcnt(5)" ::: "memory"); else asm volatile("s_waitcnt vmcnt(4)" ::: "memory"); } else asm volatile("s_waitcnt vmcnt(0)" ::: "memory"); } while (0)
#define RESC(a) do { if (__any((a) < 1.f)) { if (hi == 0) al_l[r32] = (a); asm volatile("s_waitcnt lgkmcnt(0)" ::: "memory"); \
    _Pragma("unroll") for (int d = 0; d < 4; ++d) _Pragma("unroll") for (int r = 0; r < 16; ++r) o[d][r] *= al_l[crow(r, hi)]; } } while (0)
    f32x16 p0, p1; float mn, al; bf16x8 pa0, pa1, pa2, pa3;
    SLOAD(0, 0); asm volatile("s_waitcnt vmcnt(0)" ::: "memory"); SWRITE(0, 0); __syncthreads();
    for (int t = 0; t < NT; ++t) {
        const int cb = t & 1;
        if (t + 1 < NT) SLOAD(0, t + 1);
        SBAR(); qkt<DQK>(p0, p1, K_lds + cb * SHM_K, qr, r32, hi);
        mod(p0, p1, t, wid, r32, hi); partialSM<DQK>(p0, p1, m_reg, mn, al);
        RESC(al);
        finishSM(p0, p1, al, l_reg, pa0, pa1, pa2, pa3); SBAR();
        pv_d0(o, vb0 + cb * SHM_V, pa0, pa1, pa2, pa3);
        if (t + 1 < NT) { asm volatile("s_waitcnt vmcnt(0)" ::: "memory"); SWRITE(cb ^ 1, 0); }
        __syncthreads();
    }
    if (hi == 0) li_l[r32] = l_reg; asm volatile("s_waitcnt lgkmcnt(0)" ::: "memory");
    float rli[16];
#pragma unroll
    for (int r = 0; r < 16; ++r) rli[r] = __builtin_amdgcn_rcpf(li_l[crow(r, hi)]);
    bf16_t* Ow = Ob + (long)(wid * QBLK) * LDO;
#pragma unroll
    for (int r = 0; r < 16; ++r) { const int orow = crow(r, hi);
#pragma unroll
        for (int d0 = 0; d0 < 4; ++d0) { const unsigned w = pk2(o[d0][r] * rli[r], 0.f); Ow[(long)orow * LDO + d0 * 32 + r32] = (bf16_t)(w & 0xffffu); } }
#undef KROW
#undef SLOAD
#undef SWRITE
#undef SWAIT
#undef RESC
}
}

#ifndef MLA_SDEPTH
#define MLA_SDEPTH 1
#endif
__device__ __forceinline__ void phase_mla_attn(const Params& p, const Frame& F, unsigned char* lds) {
    const bf16_t* Q = (const bf16_t*)(p.ws + WS_Q); const bf16_t* KV = (const bf16_t*)(p.ws + WS_KV); const bf16_t* KPE = (const bf16_t*)(p.ws + WS_KPE);
    bf16_t* O = (bf16_t*)(p.ws + WS_H);
    for (int u = F.vcu; u < 1024 + 64; u += F.G) {
        int b, h, qrow, NT;
        if (u < 1024) { const int bh = u >> 4, qt = u & 15; b = bh >> 4; h = bh & 15; qrow = b * TB + CTXL + qt * 256; NT = TB / 64; }
        else { const int cu = u - 1024; b = cu >> 4; h = cu & 15; qrow = b * TB; NT = CTXL / 64; }
        const size_t brow = (size_t)b * TB;
        __syncthreads();
        att::attn_body<192, NQ, NKV, NKV, DM, MLA_SDEPTH, att::NoMod>(Q + (size_t)qrow * NQ + h * 192, KV + brow * NKV + h * 256, KPE + brow * 64, KV + brow * NKV + h * 256 + 128,
                                                               O + (size_t)qrow * DM + h * 128, NT, 0, att::NoMod{}, (char*)lds);
    }
}
__device__ __forceinline__ void phase_na_attn(const Params& p, const Frame& F, unsigned char* lds) {
    const bf16_t* QKV = (const bf16_t*)(p.ws + WS_Q); bf16_t* O = (bf16_t*)(p.ws + WS_H);
    float* btab = (float*)(lds + att::Lds<128>::BT_OFF);
    for (int u = F.vcu; u < 1024; u += F.G) {
        const int bh = u >> 4, g = u & 15, b = bh >> 4, h = bh & 15, r0 = 4 * g;
        int lo = min(max(r0 - 4, 0), 56), hi_ = min(max(r0 - 1, 0), 56) + 8;
        if ((hi_ - lo) & 1) { if (lo > 0) --lo; else ++hi_; }
        const int NT = 4 + (hi_ - lo);
        const size_t brow = (size_t)b * TB; const int qrow = b * TB + CTXL + r0 * 64;
        __syncthreads();
        if (F.tid < 15 * 31) btab[F.tid] = p.na_bias[h * (15 * 31) + F.tid] * (1.0f / att::Sc<128>::SCALE);
        att::NaMod mod{btab, r0, lo};
        att::attn_body<128, NQKV, NQKV, NQKV, DM, 1, att::NaMod>(QKV + (size_t)qrow * NQKV + h * 128, QKV + brow * NQKV + DM + h * 128, nullptr, QKV + brow * NQKV + 2 * DM + h * 128,
                                                              O + (size_t)qrow * DM + h * 128, NT, lo * 64, mod, (char*)lds);
    }
}

constexpr int NPHASES = 18;
__global__ void __launch_bounds__(NTHREADS) mega_fwd(Params p) {
    extern __shared__ __attribute__((aligned(16))) unsigned char lds_raw[];
    LAS unsigned char* lds = (LAS unsigned char*)lds_raw;
    Frame F; F.tid = threadIdx.x; F.lane = F.tid & 63; F.wave = __builtin_amdgcn_readfirstlane(F.tid >> 6);
    F.G = gridDim.x; { const int bx = blockIdx.x; F.vcu = (F.G % 8 == 0) ? (bx % 8) * (F.G / 8) + bx / 8 : bx; }
    cg::grid_group grid = cg::this_grid();
    unsigned char* ws = p.ws;
    const int lo = p.ph_lo, hi = p.ph_hi;
    float* XC = (float*)(ws + WS_XC); const float* MOD = (const float*)(ws + WS_MOD);
#ifndef PHASE_MASK
#define PHASE_MASK 0x3ffff
#endif
#define IN(k) (((PHASE_MASK >> (k)) & 1) && lo <= (k) && (k) < hi)
#define SEAM(k) do { if (IN(k) && IN((k) + 1)) grid.sync(); } while (0)

    if (IN(0)) { phase0(p, F, lds); } SEAM(0);
    if (IN(1)) { phase_norm<true>(p, F, 0, 0, false); } SEAM(1);
    if (IN(2)) {
        pg8::Gemm g{(const bf16_t*)(ws + WS_H), (const bf16_t*)(ws + WS_WA), TROWS, NA_, DM}; pg8::StaticOrder S; S.init(TROWS, NA_, F.G, (int)blockIdx.x);
        pg8::EpiF32 E{(float*)(ws + WS_QA), NA_, nullptr};
        pg8::gemm_phase<pg8::EpiF32, pg8::StaticOrder, false>(lds, g, S, E, nullptr);
    } SEAM(2);
    if (IN(3)) { phase_mla_norm(p, F); } SEAM(3);
    if (IN(4)) {
        { pg8::Gemm g{(const bf16_t*)(ws + WS_CQ), (const bf16_t*)(ws + WS_WUQ), TROWS, NQ, 512}; pg8::StaticOrder S; S.init(TROWS, NQ, F.G, (int)blockIdx.x);
          EpiQ E{(bf16_t*)(ws + WS_Q), (const f32x2*)(ws + WS_ROPE)};
          pg8::gemm_phase<EpiQ, pg8::StaticOrder, false>(lds, g, S, E, nullptr); }
        { pg8::Gemm g{(const bf16_t*)(ws + WS_CKV), (const bf16_t*)(ws + WS_WUKV), TROWS, NKV, 512}; pg8::StaticOrder S; S.init(TROWS, NKV, F.G, (int)blockIdx.x);
          pg8::EpiBf16<0> E{(bf16_t*)(ws + WS_KV), NKV, nullptr, 0, 0};
          pg8::gemm_phase<pg8::EpiBf16<0>, pg8::StaticOrder, false>(lds, g, S, E, nullptr); }
    } SEAM(4);
    if (IN(5)) { phase_mla_attn(p, F, lds_raw); } SEAM(5);
    if (IN(6)) {
        pg8::Gemm g{(const bf16_t*)(ws + WS_H), (const bf16_t*)(ws + WS_WO0), TROWS, DM, DM}; pg8::StaticOrder S; S.init(TROWS, DM, F.G, (int)blockIdx.x);
        EpiRes E{p.x, p.ctx, p.out, XC, MOD + 2 * DM};
        pg8::gemm_phase<EpiRes, pg8::StaticOrder, false>(lds, g, S, E, nullptr);
    } SEAM(6);
    if (IN(7)) { phase_norm<false>(p, F, 0, 1, false); } SEAM(7);
    if (IN(8)) {
        pg8::Gemm g{(const bf16_t*)(ws + WS_H), (const bf16_t*)(ws + WS_WGU0), TROWS, NGU, DM}; pg8::StaticOrder S; S.init(TROWS, NGU, F.G, (int)blockIdx.x);
        EpiSwiglu E{(bf16_t*)(ws + WS_ACT)};
        pg8::gemm_phase<EpiSwiglu, pg8::StaticOrder, false>(lds, g, S, E, nullptr);
    } SEAM(8);
    if (IN(9)) {
        pg8::Gemm g{(const bf16_t*)(ws + WS_ACT), (const bf16_t*)(ws + WS_WD0), TROWS, DM, DFF}; pg8::StaticOrder S; S.init(TROWS, DM, F.G, (int)blockIdx.x);
        EpiRes E{p.out, XC, p.out, XC, MOD + 5 * DM};
        pg8::gemm_phase<EpiRes, pg8::StaticOrder, false>(lds, g, S, E, nullptr);
    } SEAM(9);
    if (IN(10)) { phase_norm<false>(p, F, 1, 0, false); } SEAM(10);
    if (IN(11)) {
        pg8::Gemm g{(const bf16_t*)(ws + WS_H), (const bf16_t*)(ws + WS_WQKV), TROWS, NQKV, DM}; pg8::StaticOrder S; S.init(TROWS, NQKV, F.G, (int)blockIdx.x);
        pg8::EpiBf16<0> E{(bf16_t*)(ws + WS_Q), NQKV, nullptr, 0, 0};
        pg8::gemm_phase<pg8::EpiBf16<0>, pg8::StaticOrder, false>(lds, g, S, E, nullptr);
    } SEAM(11);
    if (IN(12)) { phase_na_attn(p, F, lds_raw); } SEAM(12);
    if (IN(13)) {
        pg8::Gemm g{(const bf16_t*)(ws + WS_H), (const bf16_t*)(ws + WS_WO1), TROWS, DM, DM}; LatentOrder S; S.init(NBATCH * SEQ, DM, F.G, (int)blockIdx.x);
        EpiRes E{p.out, XC, p.out, XC, MOD + 5 * 6 * DM + 2 * DM};
        pg8::gemm_phase<EpiRes, LatentOrder, false>(lds, g, S, E, nullptr);
    } SEAM(13);
    if (IN(14)) { phase_norm<false>(p, F, 1, 1, true); } SEAM(14);
    if (IN(15)) {
        pg8::Gemm g{(const bf16_t*)(ws + WS_H), (const bf16_t*)(ws + WS_WGU1), TROWS, NGU, DM}; LatentOrder S; S.init(NBATCH * SEQ, NGU, F.G, (int)blockIdx.x);
        EpiSwiglu E{(bf16_t*)(ws + WS_ACT)};
        pg8::gemm_phase<EpiSwiglu, LatentOrder, false>(lds, g, S, E, nullptr);
    } SEAM(15);
    if (IN(16)) {
        pg8::Gemm g{(const bf16_t*)(ws + WS_ACT), (const bf16_t*)(ws + WS_WD1), TROWS, DM, DFF}; LatentOrder S; S.init(NBATCH * SEQ, DM, F.G, (int)blockIdx.x);
        EpiRes E{p.out, XC, p.out, XC, MOD + 5 * 6 * DM + 5 * DM};
        pg8::gemm_phase<EpiRes, LatentOrder, false>(lds, g, S, E, nullptr);
    } SEAM(16);
    if (IN(17)) { phase_final(p, F); }
#undef IN
#undef SEAM
}

extern "C" void kernel_launch(void* const* d_in, const int* in_sizes, int n_in, void* d_out, int out_size, void* d_ws, size_t ws_size, hipStream_t stream) {
    static int grid = 0;
    if (grid == 0) {
        if (n_in != 22 || in_sizes[0] != NBATCH * SEQ * DM || out_size != NBATCH * SEQ * DM || ws_size < WS_END) {
            fprintf(stderr, "kernel_launch: shape/workspace mismatch: n_in %d in0 %d out %d ws %zu (need %zu)\n", n_in, n_in > 0 ? in_sizes[0] : -1, out_size, ws_size, (size_t)WS_END); grid = -1; return; }
        int dev = 0, cus = 0, per_cu = 0;
        hipGetDevice(&dev); hipDeviceGetAttribute(&cus, hipDeviceAttributeMultiprocessorCount, dev);
        if (hipFuncSetAttribute((const void*)mega_fwd, hipFuncAttributeMaxDynamicSharedMemorySize, LDS_BYTES) != hipSuccess) { fprintf(stderr, "kernel_launch: hipFuncSetAttribute failed\n"); grid = -1; return; }
        if (hipOccupancyMaxActiveBlocksPerMultiprocessor(&per_cu, (const void*)mega_fwd, NTHREADS, LDS_BYTES) != hipSuccess || per_cu < 1) { fprintf(stderr, "kernel_launch: occupancy query says %d\n", per_cu); per_cu = 1; }
        (void)hipGetLastError();
        grid = cus * 1;
        fprintf(stderr, "kernel_launch: grid %d (cus %d, per_cu %d)\n", grid, cus, per_cu);
    }
    if (grid < 0) return;
    Params p{};
    const float* const* in = (const float* const*)d_in;
    p.x = in[0]; p.c = in[1]; p.ctx = in[2]; p.c_ctx = in[3]; p.ada_w = in[4]; p.ada_b = in[5]; p.norm_mix = in[6]; p.norm_ffn = in[7]; p.norm_final = in[8];
    p.w_dq = in[9]; p.q_norm = in[10]; p.w_uq = in[11]; p.w_dkv = in[12]; p.kv_norm = in[13]; p.w_ukv = in[14]; p.mla_wo = in[15];
    p.na_wqkv = in[16]; p.na_bias = in[17]; p.na_wo = in[18]; p.w_gate = in[19]; p.w_up = in[20]; p.w_down = in[21];
    p.out = (float*)d_out; p.ws = (unsigned char*)d_ws;
#if MK_ONE_LAUNCH
    p.ph_lo = 0; p.ph_hi = NPHASES;
    void* args[] = {&p};
    hipError_t e = hipLaunchCooperativeKernel((const void*)mega_fwd, dim3(grid), dim3(NTHREADS), args, LDS_BYTES, stream);
    if (e != hipSuccess) fprintf(stderr, "cooperative launch failed: %s (grid %d)\n", hipGetErrorString(e), grid);
#else
    for (int k = 0; k < NPHASES; ++k) { p.ph_lo = k; p.ph_hi = k + 1; hipLaunchKernelGGL(mega_fwd, dim3(grid), dim3(NTHREADS), LDS_BYTES, stream, p); }
#endif
}
```

```cpp
#define MK_ONE_LAUNCH 1
#include <hip/hip_runtime.h>
namespace pg8 {
#define PG8_LAS __attribute__((address_space(3)))
typedef unsigned short bf16_t;
typedef short bf16x8 __attribute__((ext_vector_type(8)));
typedef float f32x4 __attribute__((ext_vector_type(4)));
typedef unsigned u32x4 __attribute__((ext_vector_type(4)));
constexpr int BM = 256, BK = 64, HALF = 128, HTB = HALF * BK * 2  , STAGE_BYTES = 8 * HTB, NXCD = 8, WGM = 2;

__host__ __device__ __forceinline__ int lds_byte(int r, int c) { const int st = (r >> 4) * 2 + (c >> 5), rr = r & 15, cc = c & 31, ob = rr * 64 + cc * 2; return st * 1024 + (ob ^ (((ob >> 9) & 1) << 5)); }
__host__ __device__ __forceinline__ void stage_rc(int b, int& R, int& C) { const int st = b / 1024, sb = b % 1024, swz = sb ^ (((sb >> 9) & 1) << 5); R = (st >> 1) * 16 + swz / 64; C = (st & 1) * 32 + (swz % 64) / 2; }
__host__ __device__ __forceinline__ int perm32(int rho) { const int n = rho >> 4, i = rho & 15; return 8 * (i >> 2) + 4 * n + (i & 3); }

struct Unit { int pm, pn; int ko = 0; };
struct Gemm { const bf16_t* A; const bf16_t* Bt; int M, N, K; int ld; };

struct StaticOrder {
    int nM, nN, nwg, G, c;
    __host__ __device__ void init(int M, int N, int G_, int c_) { nM = M / BM; nN = N / BM; nwg = nM * nN; G = G_; c = c_; }
    __host__ __device__ bool next(int i, Unit& u) const {
        const long L = (long)i * G + c; if (L >= nwg) return false;
        int wgid = (int)L; { const int q = nwg / NXCD, r = nwg % NXCD, xcd = wgid % NXCD, off = wgid / NXCD; wgid = (xcd < r ? xcd * (q + 1) : r * (q + 1) + (xcd - r) * q) + off; }
        const int nig = WGM * nN, gid = wgid / nig, fm = gid * WGM, gsz = (nM - fm) < WGM ? (nM - fm) : WGM;
        u.pm = fm + ((wgid % nig) % gsz); u.pn = (wgid % nig) / gsz; return true;
    }
    __device__ __forceinline__ void a_ready(const Unit&) const {}
    __device__ __forceinline__ void done(const Unit&) const {}
};
struct CountedOrder : StaticOrder {
    const unsigned* ready; unsigned need; unsigned* tmo;
    __device__ __forceinline__ void a_ready(const Unit& u) const {
        if (threadIdx.x < 64) {
            const unsigned long long t0 = __builtin_amdgcn_s_memrealtime(); unsigned polls = 0;
            while ((unsigned)__builtin_amdgcn_readfirstlane(__hip_atomic_load(ready + 64 * u.pm, __ATOMIC_RELAXED, __HIP_MEMORY_SCOPE_AGENT)) < need) {
                if ((++polls & 255u) == 0u && __builtin_amdgcn_readfirstlane(__hip_atomic_load(tmo, __ATOMIC_RELAXED, __HIP_MEMORY_SCOPE_AGENT)) != 0u) break;
                if (__builtin_amdgcn_s_memrealtime() - t0 > 2000000ull) {
                    if (threadIdx.x == 0) { unsigned expect = 0u; __hip_atomic_compare_exchange_strong(tmo + 1, &expect, 0x600u | (unsigned)(u.pm & 0xff), __ATOMIC_RELAXED, __ATOMIC_RELAXED, __HIP_MEMORY_SCOPE_AGENT); __hip_atomic_store(tmo, 1u, __ATOMIC_RELAXED, __HIP_MEMORY_SCOPE_AGENT); }
                    break; }
                __builtin_amdgcn_s_sleep(2); }
            __builtin_amdgcn_fence(__ATOMIC_ACQUIRE, "agent");
            asm volatile("s_waitcnt vmcnt(0)" ::: "memory");
        }
#if !defined(BROKEN_HOOK_NO_BARRIER)
        asm volatile("" ::: "memory"); __builtin_amdgcn_s_barrier(); asm volatile("" ::: "memory");
#endif
    }
};

__device__ __forceinline__ unsigned cvt_pk_bf16(float lo, float hi) { unsigned r; asm volatile("v_cvt_pk_bf16_f32 %0, %1, %2" : "=v"(r) : "v"(lo), "v"(hi)); return r; }
typedef float f32x2 __attribute__((ext_vector_type(2)));
__device__ __forceinline__ f32x2 gelu_pk(f32x2 v) {
    const f32x2 av = __builtin_elementwise_abs(v), d = av * 0.2316418882f + 1.0f;
    f32x2 t; t.x = __builtin_amdgcn_rcpf(d.x); t.y = __builtin_amdgcn_rcpf(d.y);
    f32x2 q = t * 0.5307027145f + (-0.7265760135f); q = q * t + 0.7107068705f; q = q * t + (-0.142248368f); q = q * t + 0.127414796f; q = q * t;
    const f32x2 s = (v * v) * (-0.72134752044f);
    f32x2 e; e.x = __builtin_amdgcn_exp2f(s.x); e.y = __builtin_amdgcn_exp2f(s.y);
    const f32x2 m = v * (q * e), r = v - m;
    f32x2 o; o.x = v.x < 0.f ? m.x : r.x; o.y = v.y < 0.f ? m.y : r.y; return o;
}

struct EpiF32 {
    static constexpr bool PERM = false, AFTER_DRAIN = false;
    float* C; int ldc; const float* bias;
    __device__ __forceinline__ void operator()(const f32x4 (&acc)[2][2][4][2], const Unit& u, int wr, int wc, int fr, int fq) const {
        const int row0 = u.pm * BM + wr * 64 + fr, col0 = u.pn * BM + wc * 32 + 4 * fq;
        f32x4 bv[2][2];
#pragma unroll
        for (int bj = 0; bj < 2; ++bj)
#pragma unroll
            for (int n = 0; n < 2; ++n) bv[bj][n] = bias ? *(const f32x4*)(bias + col0 + bj * HALF + n * 16) : (f32x4){0.f, 0.f, 0.f, 0.f};
#pragma unroll
        for (int ai = 0; ai < 2; ++ai)
#pragma unroll
            for (int m = 0; m < 4; ++m) { float* rowp = C + (size_t)(row0 + ai * HALF + m * 16) * ldc + col0;
#pragma unroll
                for (int bj = 0; bj < 2; ++bj)
#pragma unroll
                    for (int n = 0; n < 2; ++n) *(f32x4*)(rowp + bj * HALF + n * 16) = acc[ai][bj][m][n] + bv[bj][n]; }
    }
};
template <int ACT  > struct EpiBf16 {
    static constexpr bool PERM = true, AFTER_DRAIN = false;
    bf16_t* O; int ldc; const float* bias; int split_cols; size_t split_stride;
    __device__ __forceinline__ void operator()(const f32x4 (&acc)[2][2][4][2], const Unit& u, int wr, int wc, int fr, int fq) const {
        const int row0 = u.pm * BM + wr * 64 + fr; int colt = u.pn * BM; bf16_t* base = O;
        if (split_cols) { const int t = colt / split_cols; base += (size_t)t * split_stride; colt -= t * split_cols; }
        const int col0 = colt + wc * 32 + 8 * fq, bcol0 = u.pn * BM + wc * 32 + 8 * fq;
        f32x4 bv[2][2];
#pragma unroll
        for (int bj = 0; bj < 2; ++bj)
#pragma unroll
            for (int n = 0; n < 2; ++n) bv[bj][n] = bias ? *(const f32x4*)(bias + bcol0 + bj * HALF + 4 * n) : (f32x4){0.f, 0.f, 0.f, 0.f};
#pragma unroll
        for (int ai = 0; ai < 2; ++ai)
#pragma unroll
            for (int m = 0; m < 4; ++m) { bf16_t* rowp = base + (size_t)(row0 + ai * HALF + m * 16) * ldc + col0;
#pragma unroll
                for (int bj = 0; bj < 2; ++bj) { f32x4 v0 = acc[ai][bj][m][0] + bv[bj][0], v1 = acc[ai][bj][m][1] + bv[bj][1];
                    if (ACT == 1) { f32x2 a = gelu_pk((f32x2){v0[0], v0[1]}), b = gelu_pk((f32x2){v0[2], v0[3]}), c = gelu_pk((f32x2){v1[0], v1[1]}), d = gelu_pk((f32x2){v1[2], v1[3]});
                        v0 = (f32x4){a.x, a.y, b.x, b.y}; v1 = (f32x4){c.x, c.y, d.x, d.y}; }
                    if (ACT == 2) {
#pragma unroll
                        for (int j = 0; j < 4; ++j) { v0[j] = 0.5f * v0[j] * (1.0f + erff(v0[j] * 0.70710678f)); v1[j] = 0.5f * v1[j] * (1.0f + erff(v1[j] * 0.70710678f)); } }
                    u32x4 w; w.x = cvt_pk_bf16(v0[0], v0[1]); w.y = cvt_pk_bf16(v0[2], v0[3]); w.z = cvt_pk_bf16(v1[0], v1[1]); w.w = cvt_pk_bf16(v1[2], v1[3]);
                    *(u32x4*)(rowp + bj * HALF) = w; } }
    }
};

template <class Epi, class Sched, bool STAMP = false, bool ALIGN_EPI = true, bool SP2 = true>
__device__ __forceinline__ void gemm_phase(PG8_LAS unsigned char* lds, const Gemm g, const Sched& S, const Epi& E, unsigned long long* stamps, const int tid_in) {
    const int tid = tid_in, wid = __builtin_amdgcn_readfirstlane(tid >> 6), lane = tid & 63, wr = wid >> 2, wc = wid & 3, fr = lane & 15, fq = lane >> 4;
    const int K = g.ld, nt = g.K / BK;
    int ts_lo = 0, ts_hi = 0, nts = 0; const unsigned long long rt_entry = STAMP ? (unsigned long long)wall_clock64() : 0ull;
#define PG8_STAMP() do { if (STAMP && wid == 0 && nts < 64) { const unsigned long long _c = (unsigned long long)clock64(); \
        ts_lo = (lane == nts) ? (int)(unsigned)_c : ts_lo; ts_hi = (lane == nts) ? (int)(unsigned)(_c >> 32) : ts_hi; ++nts; } } while (0)
    PG8_STAMP();
    unsigned voffA[2], voffB[2];
#pragma unroll
    for (int i = 0; i < 2; ++i) { int R, C; stage_rc(tid * 16 + i * 8192, R, C); const int Rb = Epi::PERM ? ((R & ~31) + perm32(R & 31)) : R;
        voffA[i] = (unsigned)(R * K + C) * 2u; voffB[i] = (unsigned)(Rb * K + C) * 2u; }
    const size_t kstep = (size_t)(BK * 2);
    const size_t hstep = (size_t)HALF * K * 2;
    const size_t tstep = 2 * hstep;
    const unsigned ldsw = (unsigned)wid * 1024u;
    const int aoff = lds_byte(wr * 64 + fr, fq * 8), boff = lds_byte(wc * 32 + fr, fq * 8);
#define PG8_SA(b, h) (((b) * 2 + (h)) * HTB)
#define PG8_SB(b, h) ((4 + (b) * 2 + (h)) * HTB)
#define PG8_STAGE(bufoff, gbase, voff) do { _Pragma("unroll") for (int _i = 0; _i < 2; ++_i) \
        __builtin_amdgcn_global_load_lds((const unsigned*)((const char*)(gbase) + (voff)[_i]), (PG8_LAS unsigned*)(lds + (bufoff) + ldsw + _i * 8192), 16, 0, 0); } while (0)
#define PG8_LDA(dst, b, h) do { _Pragma("unroll") for (int m = 0; m < 4; ++m) _Pragma("unroll") for (int k = 0; k < 2; ++k) dst[m][k] = *(const PG8_LAS bf16x8*)(lds + PG8_SA(b, h) + aoff + m * 2048 + k * 1024); } while (0)
#define PG8_LDB(dst, b, h) do { _Pragma("unroll") for (int n = 0; n < 2; ++n) _Pragma("unroll") for (int k = 0; k < 2; ++k) dst[n][k] = *(const PG8_LAS bf16x8*)(lds + PG8_SB(b, h) + boff + n * 2048 + k * 1024); } while (0)
#define PG8_MMA(ai, bj, At, Bt) do { __builtin_amdgcn_s_setprio(1); _Pragma("unroll") for (int m = 0; m < 4; ++m) _Pragma("unroll") for (int n = 0; n < 2; ++n) _Pragma("unroll") for (int k = 0; k < 2; ++k) \
        acc[ai][bj][m][n] = __builtin_amdgcn_mfma_f32_16x16x32_bf16(Bt[n][k], At[m][k], acc[ai][bj][m][n], 0, 0, 0); __builtin_amdgcn_s_setprio(0); } while (0)
#define PG8_WAIT_V(n) asm volatile("s_waitcnt vmcnt(" #n ")" ::: "memory")
#define PG8_WAIT_L(n) asm volatile("s_waitcnt lgkmcnt(" #n ")" ::: "memory")
#define PG8_BAR __builtin_amdgcn_s_barrier()
#define PG8_SCHED __builtin_amdgcn_sched_barrier(0)
    Unit cur, nxt; int ui = 0;
    if (!S.next(0, cur)) return;
    f32x4 acc[2][2][4][2];
#pragma unroll
    for (int a = 0; a < 2; ++a)
#pragma unroll
        for (int b = 0; b < 2; ++b)
#pragma unroll
            for (int m = 0; m < 4; ++m)
#pragma unroll
                for (int n = 0; n < 2; ++n) acc[a][b][m][n] = (f32x4){0.f, 0.f, 0.f, 0.f};
    bf16x8 At[4][2], B0[2][2], B1[2][2];
    const char* cA = (const char*)g.A + (size_t)cur.pm * tstep + (size_t)cur.ko; const char* cB = (const char*)g.Bt + (size_t)cur.pn * tstep + (size_t)cur.ko;
    S.a_ready(cur);
    if constexpr (SP2) {
        PG8_STAGE(PG8_SB(0, 0), cB, voffB); PG8_STAGE(PG8_SB(0, 1), cB + hstep, voffB); PG8_STAGE(PG8_SA(0, 0), cA, voffA); PG8_STAGE(PG8_SA(0, 1), cA + hstep, voffA);
        if (wr == 1) PG8_BAR;
        PG8_WAIT_V(2); PG8_BAR;
        PG8_STAGE(PG8_SB(1, 0), cB + kstep, voffB); PG8_STAGE(PG8_SA(1, 0), cA + kstep, voffA); PG8_STAGE(PG8_SB(1, 1), cB + hstep + kstep, voffB);
        PG8_WAIT_V(6); PG8_BAR;
    } else {
        PG8_STAGE(PG8_SB(0, 0), cB, voffB); PG8_STAGE(PG8_SA(0, 0), cA, voffA); PG8_STAGE(PG8_SB(0, 1), cB + hstep, voffB); PG8_STAGE(PG8_SA(0, 1), cA + hstep, voffA);
        if (wr == 1) PG8_BAR;
        PG8_WAIT_V(4); PG8_BAR;
        PG8_STAGE(PG8_SB(1, 0), cB + kstep, voffB); PG8_STAGE(PG8_SA(1, 0), cA + kstep, voffA); PG8_STAGE(PG8_SB(1, 1), cB + hstep + kstep, voffB);
        PG8_WAIT_V(6); PG8_BAR;
    }
    PG8_STAMP();
    for (;;) {
        const bool has_next = S.next(ui + 1, nxt);
        const char* nA = has_next ? (const char*)g.A + (size_t)nxt.pm * tstep + (size_t)nxt.ko : cA; const char* nB = has_next ? (const char*)g.Bt + (size_t)nxt.pn * tstep + (size_t)nxt.ko : cB;
        for (int t = 0; t < nt; t += 2) {
            const bool last = (t == nt - 2);
            const char* a1 = cA + (size_t)(t + 1) * kstep;
            const char* a2 = last ? nA : cA + (size_t)(t + 2) * kstep; const char* b2 = last ? nB : cB + (size_t)(t + 2) * kstep;
            const char* a3 = a2 + kstep; const char* b3 = b2 + kstep;
            if (last && has_next) S.a_ready(nxt);
            if constexpr (SP2) {
            PG8_LDB(B0, 0, 0); PG8_LDB(B1, 0, 1); PG8_SCHED; PG8_LDA(At, 0, 0); PG8_STAGE(PG8_SA(1, 1), a1 + hstep, voffA);
            PG8_WAIT_V(8); PG8_WAIT_L(0); PG8_BAR; PG8_MMA(0, 0, At, B0); PG8_MMA(0, 1, At, B1); PG8_BAR; PG8_SCHED;
            PG8_LDA(At, 0, 1); PG8_STAGE(PG8_SB(0, 0), b2, voffB); PG8_STAGE(PG8_SB(0, 1), b2 + hstep, voffB); PG8_STAGE(PG8_SA(0, 0), a2, voffA);
            PG8_WAIT_V(8); PG8_WAIT_L(0); PG8_BAR; PG8_MMA(1, 0, At, B0); PG8_MMA(1, 1, At, B1); PG8_BAR; PG8_SCHED;
            PG8_LDB(B0, 1, 0); PG8_LDB(B1, 1, 1); PG8_SCHED; PG8_LDA(At, 1, 0); PG8_STAGE(PG8_SA(0, 1), a2 + hstep, voffA);
            PG8_WAIT_V(8); PG8_WAIT_L(0); PG8_BAR; PG8_MMA(0, 0, At, B0); PG8_MMA(0, 1, At, B1); PG8_BAR; PG8_SCHED;
            PG8_LDA(At, 1, 1); PG8_STAGE(PG8_SB(1, 0), b3, voffB); PG8_STAGE(PG8_SB(1, 1), b3 + hstep, voffB); PG8_STAGE(PG8_SA(1, 0), a3, voffA);
            PG8_WAIT_V(8); PG8_WAIT_L(0); PG8_BAR; PG8_MMA(1, 0, At, B0); PG8_MMA(1, 1, At, B1); PG8_BAR; PG8_SCHED;
            } else {
            PG8_LDB(B0, 0, 0); PG8_SCHED; PG8_LDA(At, 0, 0); PG8_STAGE(PG8_SA(1, 1), a1 + hstep, voffA);
            PG8_WAIT_L(8); PG8_BAR; PG8_WAIT_L(0); PG8_MMA(0, 0, At, B0); PG8_BAR; PG8_SCHED;
            PG8_LDB(B1, 0, 1); PG8_STAGE(PG8_SB(0, 0), b2, voffB);
            PG8_BAR; PG8_WAIT_L(0); PG8_MMA(0, 1, At, B1); PG8_BAR;
            PG8_LDA(At, 0, 1); PG8_STAGE(PG8_SA(0, 0), a2, voffA);
            PG8_BAR; PG8_WAIT_L(0); PG8_MMA(1, 0, At, B0); PG8_BAR; PG8_SCHED;
            PG8_STAGE(PG8_SB(0, 1), b2 + hstep, voffB);
            PG8_WAIT_V(6); PG8_BAR; PG8_MMA(1, 1, At, B1); PG8_BAR;
            PG8_LDB(B0, 1, 0); PG8_SCHED; PG8_LDA(At, 1, 0); PG8_STAGE(PG8_SA(0, 1), a2 + hstep, voffA);
            PG8_WAIT_L(8); PG8_BAR; PG8_WAIT_L(0); PG8_MMA(0, 0, At, B0); PG8_BAR; PG8_SCHED;
            PG8_LDB(B1, 1, 1); PG8_STAGE(PG8_SB(1, 0), b3, voffB);
            PG8_BAR; PG8_WAIT_L(0); PG8_MMA(0, 1, At, B1); PG8_BAR;
            PG8_LDA(At, 1, 1); PG8_STAGE(PG8_SA(1, 0), a3, voffA);
            PG8_BAR; PG8_WAIT_L(0); PG8_MMA(1, 0, At, B0); PG8_BAR; PG8_SCHED;
            PG8_STAGE(PG8_SB(1, 1), b3 + hstep, voffB);
            PG8_WAIT_V(6); PG8_BAR; PG8_MMA(1, 1, At, B1); PG8_BAR;
            }
        }
        PG8_STAMP();
        if constexpr (ALIGN_EPI) { if (wr == 0) PG8_BAR; }
        if constexpr (!Epi::AFTER_DRAIN) { E(acc, cur, wr, wc, fr, fq); S.done(cur); }
        PG8_STAMP();
        if (!has_next) break;
#pragma unroll
        for (int a = 0; a < 2; ++a)
#pragma unroll
            for (int b = 0; b < 2; ++b)
#pragma unroll
                for (int m = 0; m < 4; ++m)
#pragma unroll
                    for (int n = 0; n < 2; ++n) acc[a][b][m][n] = (f32x4){0.f, 0.f, 0.f, 0.f};
        cur = nxt; cA = nA; cB = nB; ++ui;
        if constexpr (ALIGN_EPI) { if (wr == 1) PG8_BAR; }
    }
    PG8_WAIT_V(0);
    if constexpr (!ALIGN_EPI) { if (wr == 0) PG8_BAR; }
    PG8_BAR;
    if constexpr (Epi::AFTER_DRAIN) { E.fused(acc, cur, wr, wc, fr, fq, lds, wid, lane); S.done(cur); }
    PG8_STAMP();
    if (STAMP && wid == 0) { stamps[lane] = lane < nts ? (((unsigned long long)(unsigned)ts_hi << 32) | (unsigned)ts_lo) : 0ull;
        if (lane == 62) stamps[62] = rt_entry; if (lane == 63) stamps[63] = (unsigned long long)wall_clock64(); }
#undef PG8_STAMP
#undef PG8_SA
#undef PG8_SB
#undef PG8_STAGE
#undef PG8_LDA
#undef PG8_LDB
#undef PG8_MMA
#undef PG8_WAIT_V
#undef PG8_WAIT_L
#undef PG8_BAR
#undef PG8_SCHED
}
}


#include <hip/hip_cooperative_groups.h>
#include <cstdio>
#include <utility>
namespace cg = cooperative_groups;

#ifndef MK_ONE_LAUNCH
#define MK_ONE_LAUNCH 1
#endif

#define LAS __attribute__((address_space(3)))
typedef unsigned short bf16_t;
typedef short bf16x8 __attribute__((ext_vector_type(8)));
typedef short s16x4 __attribute__((ext_vector_type(4)));
typedef float f32x4 __attribute__((ext_vector_type(4)));
typedef float f32x2 __attribute__((ext_vector_type(2)));
typedef float f32x8 __attribute__((ext_vector_type(8)));
typedef float f32x16 __attribute__((ext_vector_type(16)));
typedef unsigned u32x4 __attribute__((ext_vector_type(4)));
typedef unsigned u32x2 __attribute__((ext_vector_type(2)));

constexpr int DM = 2048, NBATCH = 4, SEQ = 4096, CTXL = 256, TB = SEQ + CTXL  , TROWS = NBATCH * TB  ;
constexpr int NH = 16, DFF = 5632, NA_ = 1280  , NQ = 3072, NKV = 4096, NQKV = 6144, NGU = 2 * DFF;
constexpr int NWAVES = 8, NTHREADS = 512;
constexpr float EPS = 1e-6f;

constexpr size_t al256(size_t x) { return (x + 255) / 256 * 256; }
constexpr size_t WS_WA = 0;
constexpr size_t WS_WUQ = WS_WA + al256((size_t)NA_ * DM * 2);
constexpr size_t WS_WUKV = WS_WUQ + al256((size_t)NQ * 512 * 2);
constexpr size_t WS_WO0 = WS_WUKV + al256((size_t)NKV * 512 * 2);
constexpr size_t WS_WQKV = WS_WO0 + al256((size_t)DM * DM * 2);
constexpr size_t WS_WO1 = WS_WQKV + al256((size_t)NQKV * DM * 2);
constexpr size_t WS_WGU0 = WS_WO1 + al256((size_t)DM * DM * 2);
constexpr size_t WS_WGU1 = WS_WGU0 + al256((size_t)NGU * DM * 2);
constexpr size_t WS_WD0 = WS_WGU1 + al256((size_t)NGU * DM * 2);
constexpr size_t WS_WD1 = WS_WD0 + al256((size_t)DM * DFF * 2);
constexpr size_t WS_MOD = WS_WD1 + al256((size_t)DM * DFF * 2);
constexpr size_t WS_ROPE = WS_MOD + al256((size_t)2 * 5 * 6 * DM * 4);
constexpr size_t WS_CTL = WS_ROPE + al256(64 * 16 * 8);
constexpr size_t WS_XC = WS_CTL + 16384;
constexpr size_t WS_H = WS_XC + al256((size_t)NBATCH * CTXL * DM * 4);
constexpr size_t WS_Q = WS_H + al256((size_t)TROWS * DM * 2);
constexpr size_t WS_KV = WS_Q + al256((size_t)TROWS * NQ * 2);
constexpr size_t WS_ACT = WS_KV + al256((size_t)TROWS * NKV * 2);
constexpr size_t WS_QA = WS_ACT;
constexpr size_t WS_CQ = WS_QA + al256((size_t)TROWS * NA_ * 4);
constexpr size_t WS_CKV = WS_CQ + al256((size_t)TROWS * 512 * 2);
constexpr size_t WS_KPE = WS_CKV + al256((size_t)TROWS * 512 * 2);
constexpr size_t WS_END = WS_ACT + al256((size_t)TROWS * DFF * 2);
static_assert(WS_KPE + (size_t)TROWS * 64 * 2 <= WS_END, "alias region");
static_assert((size_t)TROWS * NQKV * 2 <= WS_ACT - WS_Q, "qkv alias");

constexpr int LDS_BYTES = 131072 + 4096;

struct Params {
    const float *x, *c, *ctx, *c_ctx, *ada_w, *ada_b, *norm_mix, *norm_ffn, *norm_final;
    const float *w_dq, *q_norm, *w_uq, *w_dkv, *kv_norm, *w_ukv, *mla_wo, *na_wqkv, *na_bias, *na_wo, *w_gate, *w_up, *w_down;
    float* out; unsigned char* ws;
    int ph_lo, ph_hi;
};

struct Frame { int tid, lane, wave, G, vcu; };

__device__ __forceinline__ unsigned pk2(float lo, float hi) { unsigned r; asm volatile("v_cvt_pk_bf16_f32 %0, %1, %2" : "=v"(r) : "v"(lo), "v"(hi)); return r; }
__device__ __forceinline__ float wave_sum(float v) {
#pragma unroll
    for (int o = 1; o < 64; o <<= 1) v += __shfl_xor(v, o);
    return v;
}
__device__ __forceinline__ float silu_f(float v) { return v / (1.0f + __expf(-v)); }
__device__ __forceinline__ int rope_perm(int d) { return d < 16 ? 2 * d : d < 32 ? 2 * (d - 16) + 1 : d < 48 ? 2 * (d - 16) : 2 * (d - 32) + 1; }

template <int KIND> __device__ __forceinline__ int dst_row(int n) {
    if (KIND == 0) return n;
    if (KIND == 1) return n < 512 ? 512 + n : 1024 + rope_perm(n - 512);
    if (KIND == 2) { const int h = n / 192, d = n - h * 192; return h * 192 + (d < 128 ? d : 128 + rope_perm(d - 128)); }
    if (KIND == 3) return (n >> 7) * 256 + (n & 127);
    return (n >> 7) * 256 + 128 + (n & 127);
}
template <int KIND>
__device__ __forceinline__ void transpose_item(const float* __restrict__ W, int K, int N, bf16_t* __restrict__ WT, LAS float* scr, int item, int lane) {
    const int nblk = N / 32, kb = item / nblk, nb = item - kb * nblk, k0 = 64 * kb, n0 = 32 * nb;
    float tv[32];
#pragma unroll
    for (int i = 0; i < 32; ++i) { const int kk = 2 * i + (lane >> 5); tv[i] = W[(size_t)(k0 + kk) * N + n0 + (lane & 31)]; }
#pragma unroll
    for (int i = 0; i < 32; ++i) { const int kk = 2 * i + (lane >> 5); scr[kk * 33 + (lane & 31)] = tv[i]; }
    asm volatile("s_waitcnt lgkmcnt(0)" ::: "memory");
    const int c = lane & 7;
#pragma unroll
    for (int j = 0; j < 4; ++j) { const int n = (lane >> 3) + 8 * j; const LAS float* s = scr + (8 * c) * 33 + n;
        u32x4 o; o.x = pk2(s[0 * 33], s[1 * 33]); o.y = pk2(s[2 * 33], s[3 * 33]); o.z = pk2(s[4 * 33], s[5 * 33]); o.w = pk2(s[6 * 33], s[7 * 33]);
        *(u32x4*)(WT + (size_t)dst_row<KIND>(n0 + n) * K + k0 + 8 * c) = o; }
    asm volatile("s_waitcnt lgkmcnt(0)" ::: "memory");
}

__device__ __forceinline__ void phase0(const Params& p, const Frame& F, LAS unsigned char* lds) {
    unsigned char* ws = p.ws;
    { const int gt = blockIdx.x * NTHREADS + F.tid;
      if (gt < 64 * 16) { const int pos = gt >> 4, f = gt & 15; const float inv = powf(10000.0f, -(float)f / 16.0f); const float ang = (float)pos * inv;
          const double a = (double)ang; const double n = rint(a * 0.15915494309189535); const float r = (float)(a - n * 6.283185307179586);
          ((f32x2*)(ws + WS_ROPE))[gt] = (f32x2){__cosf(r), __sinf(r)}; } }
    { bf16_t* wa = (bf16_t*)(ws + WS_WA) + (size_t)1088 * DM; const int n16 = 192 * DM / 8;
      for (int i = blockIdx.x * NTHREADS + F.tid; i < n16; i += F.G * NTHREADS) ((u32x4*)wa)[i] = (u32x4){0u, 0u, 0u, 0u}; }
    if ((int)blockIdx.x < 192) {
        LAS float* sc = (LAS float*)lds;
        LAS float* red = (LAS float*)(lds + 5 * 2048 * 4);
        for (int i = F.tid; i < 5 * 2048; i += NTHREADS) { const int r = i >> 11, k = i & 2047; const float v = r < 4 ? p.c[r * DM + k] : p.c_ctx[k]; sc[i] = silu_f(v); }
        __syncthreads();
        const int item = blockIdx.x, l = item / 96, nb = item % 96, n = nb * 128 + F.lane * 2;
        const float* W = p.ada_w + (size_t)l * DM * (6 * DM) + n;
        float a0[5] = {0.f, 0.f, 0.f, 0.f, 0.f}, a1[5] = {0.f, 0.f, 0.f, 0.f, 0.f};
        const int kbeg = F.wave * 256;
        for (int k = kbeg; k < kbeg + 256; k += 8) {
            f32x2 w[8];
#pragma unroll
            for (int u = 0; u < 8; ++u) w[u] = *(const f32x2*)(W + (size_t)(k + u) * (6 * DM));
#pragma unroll
            for (int r = 0; r < 5; ++r) {
                const f32x4 s0 = *(const LAS f32x4*)(sc + r * 2048 + k), s1 = *(const LAS f32x4*)(sc + r * 2048 + k + 4);
                a0[r] += s0.x * w[0].x + s0.y * w[1].x + s0.z * w[2].x + s0.w * w[3].x + s1.x * w[4].x + s1.y * w[5].x + s1.z * w[6].x + s1.w * w[7].x;
                a1[r] += s0.x * w[0].y + s0.y * w[1].y + s0.z * w[2].y + s0.w * w[3].y + s1.x * w[4].y + s1.y * w[5].y + s1.z * w[6].y + s1.w * w[7].y;
            }
        }
#pragma unroll
        for (int r = 0; r < 5; ++r) { red[(F.wave * 5 + r) * 128 + F.lane * 2] = a0[r]; red[(F.wave * 5 + r) * 128 + F.lane * 2 + 1] = a1[r]; }
        __syncthreads();
        for (int i = F.tid; i < 5 * 128; i += NTHREADS) { const int r = i >> 7, cc = i & 127; float s = 0.f;
#pragma unroll
            for (int w = 0; w < 8; ++w) s += red[(w * 5 + r) * 128 + cc];
            const int nn = nb * 128 + cc; ((float*)(ws + WS_MOD))[(size_t)(l * 5 + r) * (6 * DM) + nn] = s + p.ada_b[l * 6 * DM + nn]; }
        __syncthreads();
    }
    LAS float* scr = (LAS float*)(lds + F.wave * 16384);
    const int gw = F.vcu * NWAVES + F.wave, NGW = F.G * NWAVES;
    constexpr int I0 = 32 * 16, I1 = 32 * 18, I2 = 8 * 96, I3 = 8 * 128, I4 = 32 * 64, I5 = 32 * 192, I6 = 32 * 64, IG = 32 * 176, ID = 88 * 64;
    constexpr int NITEMS = I0 + I1 + I2 + I3 + I4 + I5 + I6 + 4 * IG + 2 * ID;
    for (int it = gw; it < NITEMS; it += NGW) {
        int r = it;
        if (r < I0) { transpose_item<0>(p.w_dq, DM, 512, (bf16_t*)(ws + WS_WA), scr, r, F.lane); continue; } r -= I0;
        if (r < I1) { transpose_item<1>(p.w_dkv, DM, 576, (bf16_t*)(ws + WS_WA), scr, r, F.lane); continue; } r -= I1;
        if (r < I2) { transpose_item<2>(p.w_uq, 512, NQ, (bf16_t*)(ws + WS_WUQ), scr, r, F.lane); continue; } r -= I2;
        if (r < I3) { transpose_item<0>(p.w_ukv, 512, NKV, (bf16_t*)(ws + WS_WUKV), scr, r, F.lane); continue; } r -= I3;
        if (r < I4) { transpose_item<0>(p.mla_wo, DM, DM, (bf16_t*)(ws + WS_WO0), scr, r, F.lane); continue; } r -= I4;
        if (r < I5) { transpose_item<0>(p.na_wqkv, DM, NQKV, (bf16_t*)(ws + WS_WQKV), scr, r, F.lane); continue; } r -= I5;
        if (r < I6) { transpose_item<0>(p.na_wo, DM, DM, (bf16_t*)(ws + WS_WO1), scr, r, F.lane); continue; } r -= I6;
        if (r < IG) { transpose_item<3>(p.w_gate, DM, DFF, (bf16_t*)(ws + WS_WGU0), scr, r, F.lane); continue; } r -= IG;
        if (r < IG) { transpose_item<4>(p.w_up, DM, DFF, (bf16_t*)(ws + WS_WGU0), scr, r, F.lane); continue; } r -= IG;
        if (r < IG) { transpose_item<3>(p.w_gate + (size_t)DM * DFF, DM, DFF, (bf16_t*)(ws + WS_WGU1), scr, r, F.lane); continue; } r -= IG;
        if (r < IG) { transpose_item<4>(p.w_up + (size_t)DM * DFF, DM, DFF, (bf16_t*)(ws + WS_WGU1), scr, r, F.lane); continue; } r -= IG;
        if (r < ID) { transpose_item<0>(p.w_down, DFF, DM, (bf16_t*)(ws + WS_WD0), scr, r, F.lane); continue; } r -= ID;
        transpose_item<0>(p.w_down + (size_t)DFF * DM, DFF, DM, (bf16_t*)(ws + WS_WD1), scr, r, F.lane);
    }
}

constexpr int NSPLIT = 4;
template <bool FROM_INPUT, bool PEND = false>
__device__ __forceinline__ void phase_norm(const Params& p, const Frame& F, int layer, int which, bool skip_ctx, const float* ctx_src = nullptr, const float* pend_gate = nullptr) {
    const int gw = F.vcu * NWAVES + F.wave, NGW = F.G * NWAVES;
    const float* gn = (which ? p.norm_ffn : p.norm_mix) + layer * DM;
    const float* mod = (const float*)(p.ws + WS_MOD) + (size_t)layer * 5 * 6 * DM;
    bf16_t* Hb = (bf16_t*)(p.ws + WS_H);
    for (int row = gw; row < TROWS; row += NGW) {
        const int b = row / TB, rb = row - b * TB; const bool isctx = rb < CTXL;
        if (isctx && skip_ctx) continue;
        const float* src;
        if (FROM_INPUT) src = isctx ? p.ctx + (size_t)(b * CTXL + rb) * DM : p.x + (size_t)(b * SEQ + rb - CTXL) * DM;
        else src = isctx ? (const float*)(p.ws + WS_XC) + (size_t)(b * CTXL + rb) * DM : p.out + (size_t)(b * SEQ + rb - CTXL) * DM;
        const float* mr = mod + (size_t)(isctx ? 4 : b) * 6 * DM + (which ? 3 : 0) * DM;
        f32x4 v[8]; float ss = 0.f;
        if (PEND && isctx) {
            const size_t ro = (size_t)(b * CTXL + rb) * DM; const float* sl = (const float*)(p.ws + WS_Q) + ro; float* xc = (float*)(p.ws + WS_XC) + ro;
#pragma unroll
            for (int j = 0; j < 8; ++j) { const int c = 4 * F.lane + 256 * j; f32x4 a = *(const f32x4*)(sl + c);
#pragma unroll
                for (int q = 1; q < NSPLIT; ++q) a += *(const f32x4*)(sl + (size_t)q * NBATCH * CTXL * DM + c);
                v[j] = *(const f32x4*)(ctx_src + ro + c) + *(const f32x4*)(pend_gate + c) * a; *(f32x4*)(xc + c) = v[j];
                ss += (v[j].x * v[j].x + v[j].y * v[j].y) + (v[j].z * v[j].z + v[j].w * v[j].w); }
        } else {
#pragma unroll
        for (int j = 0; j < 8; ++j) { v[j] = *(const f32x4*)(src + 4 * F.lane + 256 * j); ss += (v[j].x * v[j].x + v[j].y * v[j].y) + (v[j].z * v[j].z + v[j].w * v[j].w); }
        }
        const float rstd = rsqrtf(wave_sum(ss) * (1.0f / DM) + EPS);
#pragma unroll
        for (int j = 0; j < 8; ++j) { const int c = 4 * F.lane + 256 * j;
            const f32x4 g = *(const f32x4*)(gn + c), sh = *(const f32x4*)(mr + c), sc = *(const f32x4*)(mr + DM + c);
            const f32x4 y = (v[j] * rstd * g) * (sc + 1.0f) + sh;
            u32x2 o; o.x = pk2(y.x, y.y); o.y = pk2(y.z, y.w);
            *(u32x2*)(Hb + (size_t)row * DM + c) = o; }
    }
}

__device__ __forceinline__ void phase_mla_norm(const Params& p, const Frame& F) {
    const int gw = F.vcu * NWAVES + F.wave, NGW = F.G * NWAVES;
    const bf16_t* QA = (const bf16_t*)(p.ws + WS_QA);
    bf16_t* CQ = (bf16_t*)(p.ws + WS_CQ); bf16_t* CKV = (bf16_t*)(p.ws + WS_CKV); bf16_t* KPE = (bf16_t*)(p.ws + WS_KPE);
    const f32x2* rope = (const f32x2*)(p.ws + WS_ROPE);
    for (int row = gw; row < TROWS; row += NGW) {
        const int b = row / TB, rb = row - b * TB; const bool isctx = rb < CTXL;
        const bf16_t* src = QA + (size_t)row * NA_;
        const u32x4 qw = *(const u32x4*)(src + 8 * F.lane), kw = *(const u32x4*)(src + 512 + 8 * F.lane);
        const f32x4 q0 = {__uint_as_float(qw.x << 16), __uint_as_float(qw.x & 0xffff0000u), __uint_as_float(qw.y << 16), __uint_as_float(qw.y & 0xffff0000u)};
        const f32x4 q1 = {__uint_as_float(qw.z << 16), __uint_as_float(qw.z & 0xffff0000u), __uint_as_float(qw.w << 16), __uint_as_float(qw.w & 0xffff0000u)};
        const f32x4 k0 = {__uint_as_float(kw.x << 16), __uint_as_float(kw.x & 0xffff0000u), __uint_as_float(kw.y << 16), __uint_as_float(kw.y & 0xffff0000u)};
        const f32x4 k1 = {__uint_as_float(kw.z << 16), __uint_as_float(kw.z & 0xffff0000u), __uint_as_float(kw.w << 16), __uint_as_float(kw.w & 0xffff0000u)};
        const float pe = __uint_as_float((unsigned)src[1024 + F.lane] << 16);
        float sq = (q0.x * q0.x + q0.y * q0.y) + (q0.z * q0.z + q0.w * q0.w) + (q1.x * q1.x + q1.y * q1.y) + (q1.z * q1.z + q1.w * q1.w);
        float sk = (k0.x * k0.x + k0.y * k0.y) + (k0.z * k0.z + k0.w * k0.w) + (k1.x * k1.x + k1.y * k1.y) + (k1.z * k1.z + k1.w * k1.w);
        const float rq = rsqrtf(wave_sum(sq) * (1.0f / 512.0f) + EPS), rk = rsqrtf(wave_sum(sk) * (1.0f / 512.0f) + EPS);
        const f32x4 gq0 = *(const f32x4*)(p.q_norm + 8 * F.lane), gq1 = *(const f32x4*)(p.q_norm + 8 * F.lane + 4);
        const f32x4 gk0 = *(const f32x4*)(p.kv_norm + 8 * F.lane), gk1 = *(const f32x4*)(p.kv_norm + 8 * F.lane + 4);
        const f32x4 a0 = q0 * rq * gq0, a1 = q1 * rq * gq1, c0 = k0 * rk * gk0, c1 = k1 * rk * gk1;
        u32x4 o; o.x = pk2(a0.x, a0.y); o.y = pk2(a0.z, a0.w); o.z = pk2(a1.x, a1.y); o.w = pk2(a1.z, a1.w);
        *(u32x4*)(CQ + (size_t)row * 512 + 8 * F.lane) = o;
        o.x = pk2(c0.x, c0.y); o.y = pk2(c0.z, c0.w); o.z = pk2(c1.x, c1.y); o.w = pk2(c1.z, c1.w);
        *(u32x4*)(CKV + (size_t)row * 512 + 8 * F.lane) = o;
        const float other = __shfl_xor(pe, 1);
        float r = pe;
        if (!isctx) { const int s = rb - CTXL, gr = s >> 6, gc = s & 63; const int i = F.lane >> 1, f = i & 15; const int pos = i < 16 ? gr : gc;
            const f32x2 cs = rope[pos * 16 + f];
            r = (F.lane & 1) ? pe * cs.x + other * cs.y : pe * cs.x - other * cs.y; }
        const float rn = __shfl_xor(r, 1);
        if (!(F.lane & 1)) *(unsigned*)(KPE + (size_t)row * 64 + F.lane) = pk2(r, rn);
    }
}

__device__ __forceinline__ void phase_final(const Params& p, const Frame& F) {
    const int gw = F.vcu * NWAVES + F.wave, NGW = F.G * NWAVES;
    for (int row = gw; row < NBATCH * SEQ; row += NGW) {
        float* src = p.out + (size_t)row * DM;
        f32x4 v[8]; float ss = 0.f;
#pragma unroll
        for (int j = 0; j < 8; ++j) { v[j] = *(const f32x4*)(src + 4 * F.lane + 256 * j); ss += (v[j].x * v[j].x + v[j].y * v[j].y) + (v[j].z * v[j].z + v[j].w * v[j].w); }
        const float rstd = rsqrtf(wave_sum(ss) * (1.0f / DM) + EPS);
#pragma unroll
        for (int j = 0; j < 8; ++j) { const int c = 4 * F.lane + 256 * j; const f32x4 g = *(const f32x4*)(p.norm_final + c); *(f32x4*)(src + c) = v[j] * rstd * g; }
    }
}

using pg8::Unit; using pg8::HALF; using pg8::BM;
struct EpiQ {
    static constexpr bool PERM = true, AFTER_DRAIN = false;
    bf16_t* O; const f32x2* rope;
    __device__ __forceinline__ void operator()(const f32x4 (&acc)[2][2][4][2], const Unit& u, int wr, int wc, int fr, int fq) const {
        const int b = u.pm / 17, j = u.pm - b * 17; const bool latent = j > 0;
#pragma unroll
        for (int bj = 0; bj < 2; ++bj) {
            const int c32 = u.pn * BM + bj * HALF + wc * 32; const int hd = c32 / 192, off = c32 - hd * 192; const bool isrope = (off >= 128) && latent; const bool colrope = off == 160;
#pragma unroll
            for (int ai = 0; ai < 2; ++ai)
#pragma unroll
                for (int m = 0; m < 4; ++m) {
                    const int row = u.pm * BM + ai * HALF + wr * 64 + m * 16 + fr;
                    f32x4 v0 = acc[ai][bj][m][0], v1 = acc[ai][bj][m][1];
                    if (isrope) { const int gr = 4 * (j - 1) + 2 * ai + wr, gc = 16 * m + fr; const int pos = colrope ? gc : gr;
                        const f32x4 t0 = *(const f32x4*)(rope + pos * 16 + 4 * fq), t1 = *(const f32x4*)(rope + pos * 16 + 4 * fq + 2);
                        f32x4 w0, w1;
                        w0.x = v0.x * t0.x - v0.y * t0.y; w0.y = v0.y * t0.x + v0.x * t0.y; w0.z = v0.z * t0.z - v0.w * t0.w; w0.w = v0.w * t0.z + v0.z * t0.w;
                        w1.x = v1.x * t1.x - v1.y * t1.y; w1.y = v1.y * t1.x + v1.x * t1.y; w1.z = v1.z * t1.z - v1.w * t1.w; w1.w = v1.w * t1.z + v1.z * t1.w;
                        v0 = w0; v1 = w1; }
                    u32x4 w; w.x = pk2(v0[0], v0[1]); w.y = pk2(v0[2], v0[3]); w.z = pk2(v1[0], v1[1]); w.w = pk2(v1[2], v1[3]);
                    *(u32x4*)(O + (size_t)row * NQ + c32 + 8 * fq) = w; }
        }
    }
};
struct EpiRes {
    static constexpr bool PERM = false, AFTER_DRAIN = false;
    const float *src_lat, *src_ctx; float *dst_lat, *dst_ctx; const float* gate;
    __device__ __forceinline__ void operator()(const f32x4 (&acc)[2][2][4][2], const Unit& u, int wr, int wc, int fr, int fq) const {
        const int b = u.pm / 17, j = u.pm - b * 17; const bool isctx = j == 0;
        const size_t rbase = isctx ? (size_t)b * CTXL : (size_t)b * SEQ + (size_t)(j - 1) * 256;
        const float* sp = (isctx ? src_ctx : src_lat) + rbase * DM; float* dp = (isctx ? dst_ctx : dst_lat) + rbase * DM;
        const float* g = gate + (size_t)(isctx ? 4 : b) * 6 * DM;
        const int col0 = u.pn * BM + wc * 32 + 4 * fq;
        f32x4 gv[2][2];
#pragma unroll
        for (int bj = 0; bj < 2; ++bj)
#pragma unroll
            for (int n = 0; n < 2; ++n) gv[bj][n] = *(const f32x4*)(g + col0 + bj * HALF + n * 16);
#pragma unroll
        for (int ai = 0; ai < 2; ++ai)
#pragma unroll
            for (int m = 0; m < 4; ++m) { const size_t off = (size_t)(ai * HALF + wr * 64 + m * 16 + fr) * DM + col0;
#pragma unroll
                for (int bj = 0; bj < 2; ++bj)
#pragma unroll
                    for (int n = 0; n < 2; ++n) { const f32x4 r = *(const f32x4*)(sp + off + bj * HALF + n * 16); *(f32x4*)(dp + off + bj * HALF + n * 16) = r + gv[bj][n] * acc[ai][bj][m][n]; }
                asm volatile("" ::: "memory"); }
    }
};
struct EpiHeads128 {
    static constexpr bool PERM = true, AFTER_DRAIN = false;
    bf16_t* O;
    __device__ __forceinline__ void operator()(const f32x4 (&acc)[2][2][4][2], const Unit& u, int wr, int wc, int fr, int fq) const {
#pragma unroll
        for (int ai = 0; ai < 2; ++ai)
#pragma unroll
            for (int m = 0; m < 4; ++m) { const size_t row = (size_t)(u.pm * BM + ai * HALF + wr * 64 + m * 16 + fr);
#pragma unroll
                for (int bj = 0; bj < 2; ++bj) { const f32x4 v0 = acc[ai][bj][m][0], v1 = acc[ai][bj][m][1];
                    u32x4 w; w.x = pk2(v0[0], v0[1]); w.y = pk2(v0[2], v0[3]); w.z = pk2(v1[0], v1[1]); w.w = pk2(v1[2], v1[3]);
                    *(u32x4*)(O + ((size_t)(2 * u.pn + bj) * TROWS + row) * 128 + wc * 32 + 8 * fq) = w; } }
    }
};
struct EpiSwiglu {
    static constexpr bool PERM = true, AFTER_DRAIN = false;
    bf16_t* O;
    __device__ __forceinline__ void operator()(const f32x4 (&acc)[2][2][4][2], const Unit& u, int wr, int wc, int fr, int fq) const {
        const int col0 = u.pn * HALF + wc * 32 + 8 * fq;
#pragma unroll
        for (int ai = 0; ai < 2; ++ai)
#pragma unroll
            for (int m = 0; m < 4; ++m) { const int row = u.pm * BM + ai * HALF + wr * 64 + m * 16 + fr;
                f32x4 r0, r1;
#pragma unroll
                for (int e = 0; e < 4; ++e) { const float g0 = acc[ai][0][m][0][e], g1 = acc[ai][0][m][1][e];
                    r0[e] = g0 * __builtin_amdgcn_rcpf(1.0f + __expf(-g0)) * acc[ai][1][m][0][e]; r1[e] = g1 * __builtin_amdgcn_rcpf(1.0f + __expf(-g1)) * acc[ai][1][m][1][e]; }
                u32x4 w; w.x = pk2(r0[0], r0[1]); w.y = pk2(r0[2], r0[3]); w.z = pk2(r1[0], r1[1]); w.w = pk2(r1[2], r1[3]);
                *(u32x4*)(O + (size_t)row * DFF + col0) = w; }
    }
};
struct LatentOrder : pg8::StaticOrder {
    __device__ bool next(int i, Unit& u) const { if (!pg8::StaticOrder::next(i, u)) return false; u.pm = u.pm + (u.pm >> 4) + 1; return true; }
};

struct CtxSplitOrder {
    int nN, G, c, kbytes;
    __device__ void init(int N, int K, int G_, int c_) { nN = N / BM; G = G_; c = c_; kbytes = (K / NSPLIT) * 2; }
    __device__ bool next(int i, Unit& u) const { const int L = i * G + c; if (L >= 4 * nN * NSPLIT) return false; const int ks = L % NSPLIT, t = L / NSPLIT; u.pm = (t / nN) * 17; u.pn = t % nN; u.ko = ks * kbytes; return true; }
    __device__ __forceinline__ void a_ready(const Unit&) const {}
    __device__ __forceinline__ void done(const Unit&) const {}
};
struct EpiSlab {
    static constexpr bool PERM = false, AFTER_DRAIN = false;
    float* slab; int kbytes;
    __device__ __forceinline__ void operator()(const f32x4 (&acc)[2][2][4][2], const Unit& u, int wr, int wc, int fr, int fq) const {
        const int b = u.pm / 17, ks = u.ko / kbytes;
        float* dp = slab + ((size_t)ks * NBATCH * CTXL + (size_t)b * CTXL) * DM; const int col0 = u.pn * BM + wc * 32 + 4 * fq;
#pragma unroll
        for (int ai = 0; ai < 2; ++ai)
#pragma unroll
            for (int m = 0; m < 4; ++m) { const size_t off = (size_t)(ai * HALF + wr * 64 + m * 16 + fr) * DM + col0;
#pragma unroll
                for (int bj = 0; bj < 2; ++bj)
#pragma unroll
                    for (int n = 0; n < 2; ++n) *(f32x4*)(dp + off + bj * HALF + n * 16) = acc[ai][bj][m][n]; }
    }
};

namespace att {
#define SBAR() __builtin_amdgcn_sched_barrier(0)
constexpr int QBLK = 32, KVBLK = 64, DV = 128;
constexpr float THR = 8.f;
template <int DQK> struct Sc { static constexpr float SCALE = DQK == 192 ? 0.07216878364870322f : 0.08838834764831845f; };
__device__ __forceinline__ int crow(int r, int hi) { return (r & 3) + 8 * (r >> 2) + 4 * hi; }
template <int DQK> __device__ __forceinline__ int kswz_x(int row) { return DQK == 192 ? (((row >> 1) & 7) << 4) : ((row & 7) << 4); }
template <int DQK> __device__ __forceinline__ int kswz(int row, int colB) { return row * (DQK * 2) + (colB ^ kswz_x<DQK>(row)); }

template <int DQK>
__device__ __forceinline__ void partialSM(f32x16& p0, f32x16& p1, float& m_reg, float& mn, float& alpha) {
    constexpr float SCALE = Sc<DQK>::SCALE; constexpr float C = SCALE * 1.4426950408889634f;
    float pmax = p0[0];
#pragma unroll
    for (int r = 1; r < 16; ++r) pmax = fmaxf(pmax, p0[r]);
#pragma unroll
    for (int r = 0; r < 16; ++r) pmax = fmaxf(pmax, p1[r]);
    { auto rr = __builtin_amdgcn_permlane32_swap(__float_as_uint(pmax), __float_as_uint(pmax), false, false);
      pmax = fmaxf(__uint_as_float(rr[0]), __uint_as_float(rr[1])); }
    if (__builtin_expect(__all(pmax - m_reg <= THR / SCALE), 1)) { mn = m_reg; alpha = 1.f; }
    else { mn = fmaxf(m_reg, pmax); alpha = __builtin_amdgcn_exp2f((m_reg - mn) * C); m_reg = mn; }
    const float mnC = -mn * C;
#pragma unroll
    for (int r = 0; r < 16; ++r) p0[r] = fmaf(p0[r], C, mnC);
#pragma unroll
    for (int r = 0; r < 16; ++r) p1[r] = fmaf(p1[r], C, mnC);
#pragma unroll
    for (int r = 0; r < 16; ++r) p0[r] = __builtin_amdgcn_exp2f(p0[r]);
}
__device__ __forceinline__ void finishSM(f32x16& p0, f32x16& p1, float alpha, float& l_reg, bf16x8& pa0, bf16x8& pa1, bf16x8& pa2, bf16x8& pa3) {
#pragma unroll
    for (int r = 0; r < 16; ++r) p1[r] = __builtin_amdgcn_exp2f(p1[r]);
    float ps = 0;
#pragma unroll
    for (int r = 0; r < 16; ++r) ps += p0[r];
#pragma unroll
    for (int r = 0; r < 16; ++r) ps += p1[r];
    { auto rr = __builtin_amdgcn_permlane32_swap(__float_as_uint(ps), __float_as_uint(ps), false, false);
      ps = __uint_as_float(rr[0]) + __uint_as_float(rr[1]); }
    l_reg = l_reg * alpha + ps;
#define PK4(P, BASE, OUT) do { unsigned a0 = pk2(P[BASE + 0], P[BASE + 1]), a1 = pk2(P[BASE + 2], P[BASE + 3]);   \
    unsigned b0 = pk2(P[BASE + 4], P[BASE + 5]), b1 = pk2(P[BASE + 6], P[BASE + 7]);                              \
    auto r0 = __builtin_amdgcn_permlane32_swap(a0, b0, false, false); auto r1 = __builtin_amdgcn_permlane32_swap(a1, b1, false, false); \
    u32x4 w = {r0[0], r1[0], r0[1], r1[1]}; OUT = *reinterpret_cast<bf16x8*>(&w); } while (0)
    PK4(p0, 0, pa0); PK4(p0, 8, pa1); PK4(p1, 0, pa2); PK4(p1, 8, pa3);
#undef PK4
}
template <int DQK>
__device__ __forceinline__ void qkt(f32x16& p0, f32x16& p1, const char* Ks, const bf16x8* qr, int kb0, int kb1, int kb2, int kb3) {
    p0 = f32x16{}; p1 = f32x16{};
#pragma unroll
    for (int d0 = 0; d0 < DQK / 16; ++d0) { const int kb = (d0 & 3) == 0 ? kb0 : (d0 & 3) == 1 ? kb1 : (d0 & 3) == 2 ? kb2 : kb3;
        const char* a = Ks + kb + (d0 >> 2) * 128;
        const bf16x8 b0 = *reinterpret_cast<const bf16x8*>(a);
        const bf16x8 b1 = *reinterpret_cast<const bf16x8*>(a + 32 * DQK * 2);
        p0 = __builtin_amdgcn_mfma_f32_32x32x16_bf16(b0, qr[d0], p0, 0, 0, 0);
        p1 = __builtin_amdgcn_mfma_f32_32x32x16_bf16(b1, qr[d0], p1, 0, 0, 0); }
}
__device__ __forceinline__ int v_st(int k, int c) { const int kk = (k & ~0xC) | ((k & 4) << 1) | ((k & 8) >> 1); return ((kk >> 3) * 4 + (c >> 5)) * 512 + ((kk & 7) * 32 + (c & 31)) * 2; }
__device__ __forceinline__ int v_rd_base(int lane) { return ((lane & 3) << 3) | (((lane >> 2) & 3) << 6) | (((lane >> 4) & 1) << 5) | (((lane >> 5) & 1) << 8); }
constexpr int v_rd_off(int d0, int ks, int half) { return d0 * 512 + ks * 4096 + half * 2048; }
template <int OFF> __device__ __forceinline__ s16x4 tr_read(int vb) {
    s16x4 r; asm volatile("ds_read_b64_tr_b16 %0, %1 offset:%2" : "=&v"(r) : "v"(vb), "i"(OFF) : "memory"); return r;
}
template <int D0> __device__ __forceinline__ void pv_one(f32x16& od, int vb, bf16x8 pa0, bf16x8 pa1, bf16x8 pa2, bf16x8 pa3) {
    const s16x4 l0 = tr_read<v_rd_off(D0, 0, 0)>(vb), h0 = tr_read<v_rd_off(D0, 0, 1)>(vb), l1 = tr_read<v_rd_off(D0, 1, 0)>(vb), h1 = tr_read<v_rd_off(D0, 1, 1)>(vb);
    const s16x4 l2 = tr_read<v_rd_off(D0, 2, 0)>(vb), h2 = tr_read<v_rd_off(D0, 2, 1)>(vb), l3 = tr_read<v_rd_off(D0, 3, 0)>(vb), h3 = tr_read<v_rd_off(D0, 3, 1)>(vb);
    asm volatile("s_waitcnt lgkmcnt(0)" ::: "memory"); SBAR();
#define PK(L, H) (bf16x8){L[0], L[1], L[2], L[3], H[0], H[1], H[2], H[3]}
    od = __builtin_amdgcn_mfma_f32_32x32x16_bf16(pa0, PK(l0, h0), od, 0, 0, 0);
    od = __builtin_amdgcn_mfma_f32_32x32x16_bf16(pa1, PK(l1, h1), od, 0, 0, 0);
    od = __builtin_amdgcn_mfma_f32_32x32x16_bf16(pa2, PK(l2, h2), od, 0, 0, 0);
    od = __builtin_amdgcn_mfma_f32_32x32x16_bf16(pa3, PK(l3, h3), od, 0, 0, 0);
#undef PK
}
__device__ __forceinline__ void pv_d0(f32x16* o, int vb, bf16x8 pa0, bf16x8 pa1, bf16x8 pa2, bf16x8 pa3) {
    pv_one<0>(o[0], vb, pa0, pa1, pa2, pa3); pv_one<1>(o[1], vb, pa0, pa1, pa2, pa3); pv_one<2>(o[2], vb, pa0, pa1, pa2, pa3); pv_one<3>(o[3], vb, pa0, pa1, pa2, pa3);
}
template <int DQK, bool DO_QK, bool DO_PV>
__device__ __forceinline__ void mstep(f32x16& p0, f32x16& p1, f32x16* o, const char* Ks, const bf16x8* qr, int kb0, int kb1, int kb2, int kb3,
                                      const char* Vs, bf16x8 pa0, bf16x8 pa1, bf16x8 pa2, bf16x8 pa3) {
    constexpr int ND = DQK / 16, W = 3;
    bf16x8 kf0[ND], kf1[ND]; s16x4 vl[16], vh[16];
    __builtin_amdgcn_s_setprio(1);
#define LDKF(d) do { const int kb_ = ((d) & 3) == 0 ? kb0 : ((d) & 3) == 1 ? kb1 : ((d) & 3) == 2 ? kb2 : kb3; const char* a_ = Ks + kb_ + ((d) >> 2) * 128; \
    kf0[d] = *reinterpret_cast<const bf16x8*>(a_); kf1[d] = *reinterpret_cast<const bf16x8*>(a_ + 32 * DQK * 2); } while (0)
#define LDVF(m) do { vl[m] = __builtin_amdgcn_ds_read_tr16_b64_v4i16((LAS s16x4*)(Vs + v_rd_off((m) >> 2, (m) & 3, 0))); vh[m] = __builtin_amdgcn_ds_read_tr16_b64_v4i16((LAS s16x4*)(Vs + v_rd_off((m) >> 2, (m) & 3, 1))); } while (0)
    if (DO_QK) { p0 = f32x16{}; p1 = f32x16{};
#pragma unroll
        for (int d = 0; d < W; ++d) LDKF(d);
#pragma unroll
        for (int d = 0; d < ND; ++d) {
            if (d + W < ND) LDKF(d + W); else if (DO_PV) LDVF(d + W - ND);
            SBAR();
            p0 = __builtin_amdgcn_mfma_f32_32x32x16_bf16(kf0[d], qr[d], p0, 0, 0, 0);
            p1 = __builtin_amdgcn_mfma_f32_32x32x16_bf16(kf1[d], qr[d], p1, 0, 0, 0);
            SBAR(); }
    } else {
#pragma unroll
        for (int m = 0; m < W; ++m) LDVF(m);
    }
    if (DO_PV) {
#pragma unroll
        for (int m = 0; m < 16; ++m) {
            if (m + W < 16) LDVF(m + W);
            SBAR();
            const bf16x8 vv = (bf16x8){vl[m][0], vl[m][1], vl[m][2], vl[m][3], vh[m][0], vh[m][1], vh[m][2], vh[m][3]};
            const bf16x8 pa = (m & 3) == 0 ? pa0 : (m & 3) == 1 ? pa1 : (m & 3) == 2 ? pa2 : pa3;
            o[m >> 2] = __builtin_amdgcn_mfma_f32_32x32x16_bf16(pa, vv, o[m >> 2], 0, 0, 0);
            SBAR(); }
    }
    __builtin_amdgcn_s_setprio(0);
#undef LDKF
#undef LDVF
}
struct NoMod { __device__ __forceinline__ void operator()(f32x16&, f32x16&, int, int, int, int) const {} };
struct NaMod {
    const float* btab;
    int r0, lo;
    __device__ __forceinline__ void operator()(f32x16& p0, f32x16& p1, int t, int wid, int r32, int hi) const {
        if (t < 4) return;
        const int kr = lo + t - 4, r = r0 + (wid >> 1); const int rs = min(max(r - 4, 0), 56); const bool vrow = kr >= rs && kr < rs + 8;
        const int c = (wid & 1) * 32 + r32, cs = min(max(c - 8, 0), 48); const int dr = vrow ? kr - r + 7 : 0;
        const float* bt = btab + dr * 31 + 15 - c;
#pragma unroll
        for (int g = 0; g < 16; ++g) { const int kc0 = crow(g, hi), kc1 = 32 + kc0;
            const bool ok0 = vrow && kc0 >= cs && kc0 < cs + 16, ok1 = vrow && kc1 >= cs && kc1 < cs + 16;
            const float b0 = bt[ok0 ? kc0 : c - 15], b1 = bt[ok1 ? kc1 : c - 15];
            p0[g] = ok0 ? p0[g] + b0 : -1e30f; p1[g] = ok1 ? p1[g] + b1 : -1e30f; }
    }
};

template <int DQK> struct Lds { static constexpr int SHM_V = KVBLK * DV * 2, SHM_K = KVBLK * DQK * 2, WS_OFF = 2 * SHM_V + 2 * SHM_K, BT_OFF = WS_OFF + 8 * 64 * 4, TOTAL = BT_OFF + 2048; };

template <int DQK, int LDQ, int LDK, int LDV, int LDO, int G, class Mod, int PRB = 0>
__device__ __forceinline__ void attn_body(const bf16_t* __restrict__ Qb, const bf16_t* __restrict__ Kn, const bf16_t* __restrict__ Kp, const bf16_t* __restrict__ Vh,
                                          bf16_t* __restrict__ Ob, int NT, int loff, const Mod& mod, char* lds) {
    constexpr int SHM_V = Lds<DQK>::SHM_V, SHM_K = Lds<DQK>::SHM_K; constexpr bool PE = DQK == 192;
    const int tid = threadIdx.x, wid = tid >> 6, lane = tid & 63, r32 = lane & 31, hi = lane >> 5;
    char* V_lds = lds; char* K_lds = lds + 2 * SHM_V;
    float* wsl = (float*)(lds + Lds<DQK>::WS_OFF) + wid * 64; float* li_l = wsl; float* al_l = wsl + 32;
    float m_reg = -1e30f, l_reg = 0; f32x16 o[4] = {}; bf16x8 qr[DQK / 16];
    const bf16_t* Qw = Qb + (long)(wid * QBLK + r32) * LDQ + hi * 8;
#pragma unroll
    for (int d0 = 0; d0 < DQK / 16; ++d0) qr[d0] = *reinterpret_cast<const bf16x8*>(Qw + d0 * 16);
    const int sr = tid >> 4, sc = (tid & 15) * 8, vst0 = v_st(sr, sc), vst1 = v_st(32 + sr, sc);
    const int pr = tid >> 3, pc = (tid & 7) * 8;
    const int vb0 = (int)(uintptr_t)V_lds + v_rd_base(lane);
    bf16x8 vs0 = {}, vs1 = {}, ks0 = {}, ks1 = {}, kp = {};
    const unsigned ko0 = (unsigned)(sr * LDK + sc), po0 = (unsigned)(pr * 64 + pc), vo0 = (unsigned)(sr * LDV + sc);
#define KROW(t) ((t) * KVBLK + ((t) >= 4 ? loff : 0))
#define KLOAD(t) do { if (PRB & 1) break; const bf16_t* kt_ = Kn + (size_t)KROW(t) * LDK; ks0 = *reinterpret_cast<const bf16x8*>(kt_ + ko0); ks1 = *reinterpret_cast<const bf16x8*>(kt_ + 32 * LDK + ko0); \
    if constexpr (PE) { const bf16_t* pt_ = Kp + (size_t)KROW(t) * 64; kp = *reinterpret_cast<const bf16x8*>(pt_ + po0); } } while (0)
#define VLOAD(t) do { if (PRB & 1) break; const bf16_t* vt_ = Vh + (size_t)KROW(t) * LDV; vs0 = *reinterpret_cast<const bf16x8*>(vt_ + vo0); vs1 = *reinterpret_cast<const bf16x8*>(vt_ + 32 * LDV + vo0); } while (0)
#define KWRITE(b) do { const int kc = sc * 2; *(bf16x8*)(K_lds + (b) * SHM_K + kswz<DQK>(sr, kc)) = ks0; *(bf16x8*)(K_lds + (b) * SHM_K + kswz<DQK>(32 + sr, kc)) = ks1; \
    if constexpr (PE) *(bf16x8*)(K_lds + (b) * SHM_K + kswz<DQK>(pr, 256 + pc * 2)) = kp; } while (0)
#define VWRITE(b) do { *(bf16x8*)(V_lds + (b) * SHM_V + vst0) = vs0; *(bf16x8*)(V_lds + (b) * SHM_V + vst1) = vs1; } while (0)
#define RESC(a) do { if (__any((a) < 1.f)) { if (hi == 0) al_l[r32] = (a); asm volatile("s_waitcnt lgkmcnt(0)" ::: "memory"); \
    _Pragma("unroll") for (int d = 0; d < 4; ++d) _Pragma("unroll") for (int r = 0; r < 16; ++r) o[d][r] *= al_l[crow(r, hi)]; } } while (0)
#define STAGE(s_) do { const int s__ = (s_), t__ = s__ >> 1; \
    if (!(s__ & 1)) { if (t__ + 1 < NT) KLOAD(t__ + 1); if (t__ < NT) VLOAD(t__); } \
    else { asm volatile("s_waitcnt vmcnt(0)" ::: "memory"); if (t__ + 1 < NT) KWRITE((t__ + 1) & 1); if (t__ < NT) VWRITE(t__ & 1); } } while (0)
#define SOFTMAX(t_) do { if (PRB & 2) break; mod(p0, p1, (t_), wid, r32, hi); partialSM<DQK>(p0, p1, m_reg, mn, al); RESC(al); finishSM(p0, p1, al, l_reg, pa0, pa1, pa2, pa3); } while (0)
    f32x16 p0 = {}, p1 = {}; float mn, al = 1.f; bf16x8 pa0 = {}, pa1 = {}, pa2 = {}, pa3 = {};
    int kb0 = kswz<DQK>(r32, 0 * 32 + hi * 16), kb1 = kswz<DQK>(r32, 1 * 32 + hi * 16), kb2 = kswz<DQK>(r32, 2 * 32 + hi * 16), kb3 = kswz<DQK>(r32, 3 * 32 + hi * 16);
    asm volatile("" : "+v"(kb0), "+v"(kb1), "+v"(kb2), "+v"(kb3));
#define PRE(s_) do { if (G == 1) STAGE(s_); } while (0)
#define POST(s_) do { if (G == 0) STAGE(s_); } while (0)
#define ABAR() do { asm volatile("s_waitcnt lgkmcnt(0)" ::: "memory"); __builtin_amdgcn_s_barrier(); asm volatile("" ::: "memory"); } while (0)
    KLOAD(0); asm volatile("s_waitcnt vmcnt(0)" ::: "memory"); KWRITE(0); ABAR();
    if (G == 1) { STAGE(0); ABAR(); }
    const char* Vrd = V_lds + v_rd_base(lane);
    PRE(G); SBAR(); if (!(PRB & 4)) mstep<DQK, true, false>(p0, p1, o, K_lds, qr, kb0, kb1, kb2, kb3, Vrd, pa0, pa1, pa2, pa3); POST(G); ABAR();
    for (int t = 0; t < NT - 1; ++t) {
        PRE(G + 2 * t + 1); SOFTMAX(t); POST(G + 2 * t + 1); ABAR();
        PRE(G + 2 * t + 2); SBAR(); if (!(PRB & 4)) mstep<DQK, true, true>(p0, p1, o, K_lds + ((t + 1) & 1) * SHM_K, qr, kb0, kb1, kb2, kb3, Vrd + (t & 1) * SHM_V, pa0, pa1, pa2, pa3); SBAR(); POST(G + 2 * t + 2); ABAR();
    }
    PRE(G + 2 * NT - 1); SOFTMAX(NT - 1); POST(G + 2 * NT - 1); ABAR();
    SBAR(); if (!(PRB & 4)) mstep<DQK, false, true>(p0, p1, o, K_lds, qr, kb0, kb1, kb2, kb3, Vrd + ((NT - 1) & 1) * SHM_V, pa0, pa1, pa2, pa3); ABAR();
    if (G == 0) { ABAR(); }
#undef ABAR
#undef PRE
#undef POST
#undef STAGE
#undef SOFTMAX
    if (hi == 0) li_l[r32] = l_reg; asm volatile("s_waitcnt lgkmcnt(0)" ::: "memory");
    int lane_e = lane; asm volatile("" : "+v"(lane_e));
    const int r32e = lane_e & 31, hie = lane_e >> 5;
    bf16_t* Ow = Ob + (long)(wid * QBLK + 4 * hie) * LDO + r32e;
#pragma unroll
    for (int r = 0; r < 16; ++r) { const int orow = (r & 3) + 8 * (r >> 2); const float rl = __builtin_amdgcn_rcpf(li_l[orow + 4 * hie]);
#pragma unroll
        for (int d0 = 0; d0 < 4; ++d0) { const unsigned w = pk2(o[d0][r] * rl, 0.f); Ow[(long)orow * LDO + d0 * 32] = (bf16_t)(w & 0xffffu); } }
#undef KROW
#undef KLOAD
#undef VLOAD
#undef KWRITE
#undef VWRITE
#undef RESC
}

struct NoMod2 { __device__ __forceinline__ void operator()(f32x16& p, int, int, int, int, int) const { p = f32x16{}; } };
struct NaMod2 {
    const float* btab; int r0, lo;
    __device__ __forceinline__ void operator()(f32x16& p, int t, int hf, int wid, int r32, int hi) const {
        if (t < 4) { p = f32x16{}; return; }
        const int kr = lo + t - 4, r = r0 + (wid >> 1); const int rs = min(max(r - 4, 0), 56);
        if (!(kr >= rs && kr < rs + 8)) {
#pragma unroll
            for (int g = 0; g < 16; ++g) p[g] = -1e30f;
            return; }
        const int c = (wid & 1) * 32 + r32, cs = min(max(c - 8, 0), 48);
        const int d = 4 * hi + 32 * hf - cs;
        const float* bt = btab + (kr - r + 7) * 31 + 15 - c + 4 * hi + 32 * hf;
#pragma unroll
        for (int g = 0; g < 16; ++g) { const int K0 = (g & 3) + 8 * (g >> 2); const bool ok = (unsigned)(K0 + d) < 16u; const float bv = bt[K0]; p[g] = ok ? bv : -1e30f; }
    }
};
__device__ __forceinline__ float max3f(float a, float b, float c) { return __builtin_fmaxf(__builtin_fmaxf(a, b), c); }
#define PK4V(P, BASE, OUT) do { unsigned a0 = pk2(P[BASE + 0], P[BASE + 1]), a1 = pk2(P[BASE + 2], P[BASE + 3]);   \
    unsigned b0 = pk2(P[BASE + 4], P[BASE + 5]), b1 = pk2(P[BASE + 6], P[BASE + 7]);                              \
    auto r0 = __builtin_amdgcn_permlane32_swap(a0, b0, false, false); auto r1 = __builtin_amdgcn_permlane32_swap(a1, b1, false, false); \
    u32x4 w = {r0[0], r1[0], r0[1], r1[1]}; OUT = *reinterpret_cast<bf16x8*>(&w); } while (0)

template <int DQK, int HFK, int HFV, bool DO_QK, bool DO_SM, bool DO_PV, class Mod>
__device__ __forceinline__ void region(f32x16& pn, f32x16& pc, bf16x8 pal, bf16x8 pah, bf16x8& pbl, bf16x8& pbh, f32x16* o, float& m_reg, float& l_reg, float& al,
                                       const LAS char* Kb, const bf16x8* qr, int kb0, int kb1, int kb2, int kb3, const LAS char* Vrd, const Mod& mod, int tmod, int hfmod, int wid, int r32, int hi, const char* Qpe, int qx) {
    constexpr int ND = DQK / 16, NQ = DO_QK ? ND : 0, NP = DO_PV ? 8 : 0, NM = NQ + NP, W = (DQK == 192 ? 2 : 3), NS = 10;
    constexpr float SCALE = Sc<DQK>::SCALE, C = SCALE * 1.4426950408889634f, THRS = THR / SCALE;
    bf16x8 kf[ND]; s16x4 vl[8], vh[8];
    float t0 = 0.f, t1 = 0.f, t2 = 0.f, t3 = 0.f, t4 = 0.f, pmax = 0.f, mnC = 0.f, ps = 0.f;
#define LDF(j) do { if ((j) < NQ) { const int kb_ = ((j) & 3) == 0 ? kb0 : ((j) & 3) == 1 ? kb1 : ((j) & 3) == 2 ? kb2 : kb3; \
        kf[(j) < NQ ? (j) : 0] = *reinterpret_cast<const LAS bf16x8*>(Kb + kb_ + ((j) >> 2) * 128 + HFK * 32 * DQK * 2); } \
    else { constexpr int m_ = (j) - NQ >= 0 ? ((j) - NQ) & 7 : 0; \
        vl[m_] = __builtin_amdgcn_ds_read_tr16_b64_v4i16((LAS s16x4*)(LAS char*)(Vrd + v_rd_off(m_ >> 1, 2 * HFV + (m_ & 1), 0))); \
        vh[m_] = __builtin_amdgcn_ds_read_tr16_b64_v4i16((LAS s16x4*)(LAS char*)(Vrd + v_rd_off(m_ >> 1, 2 * HFV + (m_ & 1), 1))); } } while (0)
#define MMF(j) do { if ((j) < NQ) { pn = __builtin_amdgcn_mfma_f32_32x32x16_bf16(kf[(j) < NQ ? (j) : 0], qr[(j) < NQ ? (j) : 0], pn, 0, 0, 0); } \
    else { constexpr int m_ = (j) - NQ >= 0 ? ((j) - NQ) & 7 : 0; const bf16x8 vv_ = (bf16x8){vl[m_][0], vl[m_][1], vl[m_][2], vl[m_][3], vh[m_][0], vh[m_][1], vh[m_][2], vh[m_][3]}; \
        o[m_ >> 1] = __builtin_amdgcn_mfma_f32_32x32x16_bf16((m_ & 1) ? pah : pal, vv_, o[m_ >> 1], 0, 0, 0); } } while (0)
    if (DO_QK) mod(pn, tmod, hfmod, wid, r32, hi);
    [&]<int... J>(std::integer_sequence<int, J...>) { ((J < NM && J < W ? (void)([&] { LDF(J); }()) : (void)0), ...); }(std::make_integer_sequence<int, 3>{});
    [&]<int... S>(std::integer_sequence<int, S...>) {
        (([&] {
            constexpr int jb = S * NM / NS, je = (S + 1) * NM / NS;
            [&]<int... Q>(std::integer_sequence<int, Q...>) {
                (([&] { constexpr int j = jb + Q; if constexpr (j < je) { if constexpr (j + W < NM) { LDF(j + W); } MMF(j); } }()), ...);
            }(std::make_integer_sequence<int, 3>{});
            if constexpr (DO_SM) {
                if constexpr (S == 0) { t0 = max3f(pc[0], pc[1], pc[2]); t1 = max3f(pc[3], pc[4], pc[5]); t2 = max3f(pc[6], pc[7], pc[8]); }
                if constexpr (S == 1) { t3 = max3f(pc[9], pc[10], pc[11]); t4 = max3f(pc[12], pc[13], pc[14]); t0 = max3f(t0, t1, pc[15]); t2 = max3f(t2, t3, t4); pmax = fmaxf(t0, t2);
                    auto rr = __builtin_amdgcn_permlane32_swap(__float_as_uint(pmax), __float_as_uint(pmax), false, false); pmax = fmaxf(__uint_as_float(rr[0]), __uint_as_float(rr[1])); }
                if constexpr (S == 2) { const bool keep = __all(pmax - m_reg <= THRS); const float mn = keep ? m_reg : fmaxf(m_reg, pmax); al = __builtin_amdgcn_exp2f((m_reg - mn) * C); m_reg = mn; mnC = -mn * C; }
                if constexpr (S >= 3 && S <= 6) {
#pragma unroll
                    for (int r = 4 * (S - 3); r < 4 * (S - 3) + 4; ++r) pc[r] = __builtin_amdgcn_exp2f(fmaf(pc[r], C, mnC)); }
                if constexpr (S == 7) { ps = ((pc[0] + pc[1]) + (pc[2] + pc[3])) + ((pc[4] + pc[5]) + (pc[6] + pc[7])) + (((pc[8] + pc[9]) + (pc[10] + pc[11])) + ((pc[12] + pc[13]) + (pc[14] + pc[15]))); }
                if constexpr (S == 8) { auto rr = __builtin_amdgcn_permlane32_swap(__float_as_uint(ps), __float_as_uint(ps), false, false); ps = __uint_as_float(rr[0]) + __uint_as_float(rr[1]);
                    l_reg = l_reg * al + ps; PK4V(pc, 0, pbl); }
                if constexpr (S == 9) { PK4V(pc, 8, pbh); }
            }
            SBAR();
        }()), ...);
    }(std::make_integer_sequence<int, NS>{});
#undef LDF
#undef MMF
}

template <int DQK, int LDQ, int LDK, int LDV, int LDO, class Mod>
__device__ __forceinline__ void attn_body2(const bf16_t* __restrict__ Qb, const bf16_t* __restrict__ Kn, const bf16_t* __restrict__ Kp, const bf16_t* __restrict__ Vh,
                                           bf16_t* __restrict__ Ob, int NT, int loff, const Mod& mod, char* lds, const int tid) {
    constexpr int SHM_V = Lds<DQK>::SHM_V, SHM_K = Lds<DQK>::SHM_K; constexpr bool PE = DQK == 192;
    const int wid = __builtin_amdgcn_readfirstlane(tid >> 6), lane = tid & 63, r32 = lane & 31, hi = lane >> 5;
    LAS char* V_lds = (LAS char*)lds; LAS char* K_lds = V_lds + 2 * SHM_V;
    float* wsl = (float*)(lds + Lds<DQK>::WS_OFF) + wid * 64; float* li_l = wsl; float* al_l = wsl + 32;
    float m_reg = -1e30f, l_reg = 0; f32x16 o[4] = {}; bf16x8 qr[DQK / 16];
    const bf16_t* Qw = Qb + (long)(wid * QBLK + r32) * LDQ + hi * 8;
#pragma unroll
    for (int d0 = 0; d0 < DQK / 16; ++d0) qr[d0] = *reinterpret_cast<const bf16x8*>(Qw + d0 * 16);
    const int qx = 0; const char* Qpe = lds;
    const int sr = tid >> 4, sc = (tid & 15) * 8, vst0 = v_st(sr, sc), vst1 = vst0 + 8192;
    const int pr = tid >> 3, pc_ = (tid & 7) * 8;
    bf16x8 vs0 = {}, vs1 = {}, ks0 = {}, ks1 = {}, kp = {};
    const int kw0 = kswz<DQK>(sr, sc * 2), kwp = kswz<DQK>(pr, 256 + pc_ * 2);
    const unsigned ko0 = (unsigned)(sr * LDK + sc), po0 = (unsigned)(pr * 64 + pc_), vo0 = (unsigned)(sr * LDV + sc);
#define KROW(t) ((t) * KVBLK + ((t) >= 4 ? loff : 0))
#define KLOAD(t) do { const bf16_t* kt_ = Kn + (size_t)KROW(t) * LDK; ks0 = *reinterpret_cast<const bf16x8*>(kt_ + ko0); ks1 = *reinterpret_cast<const bf16x8*>(kt_ + 32 * LDK + ko0); \
    if constexpr (PE) { const bf16_t* pt_ = Kp + (size_t)KROW(t) * 64; kp = *reinterpret_cast<const bf16x8*>(pt_ + po0); } } while (0)
#define VLOAD(t) do { const bf16_t* vt_ = Vh + (size_t)KROW(t) * LDV; vs0 = *reinterpret_cast<const bf16x8*>(vt_ + vo0); vs1 = *reinterpret_cast<const bf16x8*>(vt_ + 32 * LDV + vo0); } while (0)
#define KWRITE(b) do { *(LAS bf16x8*)(K_lds + (b) * SHM_K + kw0) = ks0; *(LAS bf16x8*)(K_lds + (b) * SHM_K + kw0 + 32 * DQK * 2) = ks1; \
    if constexpr (PE) *(LAS bf16x8*)(K_lds + (b) * SHM_K + kwp) = kp; } while (0)
#define VWRITE(b) do { *(LAS bf16x8*)(V_lds + (b) * SHM_V + vst0) = vs0; *(LAS bf16x8*)(V_lds + (b) * SHM_V + vst1) = vs1; } while (0)
#define RESC(a) do { if (__any((a) < 1.f)) { if (hi == 0) al_l[r32] = (a); asm volatile("s_waitcnt lgkmcnt(0)" ::: "memory"); \
    _Pragma("unroll") for (int d = 0; d < 4; ++d) _Pragma("unroll") for (int r = 0; r < 16; ++r) o[d][r] *= al_l[crow(r, hi)]; } } while (0)
#define ABAR() do { asm volatile("s_waitcnt lgkmcnt(0)" ::: "memory"); __builtin_amdgcn_s_barrier(); asm volatile("" ::: "memory"); } while (0)
    int kb0 = kswz<DQK>(r32, 0 * 32 + hi * 16), kb1 = kswz<DQK>(r32, 1 * 32 + hi * 16), kb2 = kswz<DQK>(r32, 2 * 32 + hi * 16), kb3 = kswz<DQK>(r32, 3 * 32 + hi * 16);
    asm volatile("" : "+v"(kb0), "+v"(kb1), "+v"(kb2), "+v"(kb3));
    const LAS char* Vrd = V_lds + v_rd_base(lane);
    f32x16 P0 = {}, P1 = {}; bf16x8 A0l = {}, A0h = {}, A1l = {}, A1h = {}; float al = 1.f;
#define RA(...) __VA_ARGS__, wid, r32, hi, Qpe, qx
    KLOAD(0); VLOAD(0); asm volatile("s_waitcnt vmcnt(0)" ::: "memory"); KWRITE(0); VWRITE(0); KLOAD(1); ABAR();
    region<DQK, 0, 0, true, false, false, Mod>(P0, P1, A1l, A1h, A0l, A0h, o, m_reg, l_reg, al, K_lds, qr, kb0, kb1, kb2, kb3, Vrd, RA(mod, 0, 0));
    asm volatile("s_waitcnt vmcnt(0)" ::: "memory"); KWRITE(1); VLOAD(1);
    region<DQK, 1, 1, true, true, false, Mod>(P1, P0, A1l, A1h, A0l, A0h, o, m_reg, l_reg, al, K_lds, qr, kb0, kb1, kb2, kb3, Vrd, RA(mod, 0, 1));
    RESC(al); ABAR();
    asm volatile("s_waitcnt vmcnt(0)" ::: "memory"); VWRITE(1); if (2 < NT) KLOAD(2);
    region<DQK, 0, 0, true, true, true, Mod>(P0, P1, A0l, A0h, A1l, A1h, o, m_reg, l_reg, al, K_lds + SHM_K, qr, kb0, kb1, kb2, kb3, Vrd, RA(mod, 1, 0));
    RESC(al);
    for (int t = 1; t < NT - 1; ++t) {
        VLOAD(t + 1);
        region<DQK, 1, 1, true, true, true, Mod>(P1, P0, A1l, A1h, A0l, A0h, o, m_reg, l_reg, al, K_lds + (t & 1) * SHM_K, qr, kb0, kb1, kb2, kb3, Vrd + ((t - 1) & 1) * SHM_V, RA(mod, t, 1));
        asm volatile("s_waitcnt vmcnt(2)" ::: "memory"); KWRITE((t + 1) & 1);
        RESC(al); ABAR();
        asm volatile("s_waitcnt vmcnt(0)" ::: "memory"); VWRITE((t + 1) & 1); if (t + 2 < NT) KLOAD(t + 2);
        region<DQK, 0, 0, true, true, true, Mod>(P0, P1, A0l, A0h, A1l, A1h, o, m_reg, l_reg, al, K_lds + ((t + 1) & 1) * SHM_K, qr, kb0, kb1, kb2, kb3, Vrd + (t & 1) * SHM_V, RA(mod, t + 1, 0));
        RESC(al);
    }
    { const int t = NT - 1;
      region<DQK, 1, 1, true, true, true, Mod>(P1, P0, A1l, A1h, A0l, A0h, o, m_reg, l_reg, al, K_lds + (t & 1) * SHM_K, qr, kb0, kb1, kb2, kb3, Vrd + ((t - 1) & 1) * SHM_V, RA(mod, t, 1));
      RESC(al); ABAR();
      region<DQK, 0, 0, false, true, true, Mod>(P0, P1, A0l, A0h, A1l, A1h, o, m_reg, l_reg, al, K_lds, qr, kb0, kb1, kb2, kb3, Vrd + (t & 1) * SHM_V, RA(mod, t, 1));
      RESC(al);
      region<DQK, 0, 1, false, false, true, Mod>(P0, P1, A1l, A1h, A0l, A0h, o, m_reg, l_reg, al, K_lds, qr, kb0, kb1, kb2, kb3, Vrd + (t & 1) * SHM_V, RA(mod, t, 1)); }
#undef RA
    if (hi == 0) li_l[r32] = l_reg; asm volatile("s_waitcnt lgkmcnt(0)" ::: "memory");
    int lane_e = lane; asm volatile("" : "+v"(lane_e));
    const int r32e = lane_e & 31, hie = lane_e >> 5;
    bf16_t* Ow = Ob + (long)(wid * QBLK + 4 * hie) * LDO + r32e;
#pragma unroll
    for (int r = 0; r < 16; ++r) { const int orow = (r & 3) + 8 * (r >> 2); const float rl = __builtin_amdgcn_rcpf(li_l[orow + 4 * hie]);
#pragma unroll
        for (int d0 = 0; d0 < 4; ++d0) { const unsigned w = pk2(o[d0][r] * rl, 0.f); Ow[(long)orow * LDO + d0 * 32] = (bf16_t)(w & 0xffffu); } }
#undef KROW
#undef KLOAD
#undef VLOAD
#undef KWRITE
#undef VWRITE
#undef RESC
#undef ABAR
}
}

#ifndef ATT_V2_MLA
#define ATT_V2_MLA 1
#endif
#ifndef ATT_V2_NA
#define ATT_V2_NA 1
#endif
#ifndef MLA_SDEPTH
#define MLA_SDEPTH 1
#endif
template <int PRB = 0>
__device__ __forceinline__ void phase_mla_attn(const Params& p, const Frame& F, unsigned char* lds) {
    const bf16_t* Q = (const bf16_t*)(p.ws + WS_Q); const bf16_t* KV = (const bf16_t*)(p.ws + WS_KV); const bf16_t* KPE = (const bf16_t*)(p.ws + WS_KPE);
    bf16_t* O = (bf16_t*)(p.ws + (PRB ? WS_END : WS_H));
    for (int u = F.vcu; u < 1024 + 64; u += F.G) {
        int b, h, qrow, NT;
        if (u < 1024) { const int bh = u >> 4, qt = u & 15; b = bh >> 4; h = bh & 15; qrow = b * TB + CTXL + qt * 256; NT = TB / 64; }
        else { const int cu = u - 1024; b = cu >> 4; h = cu & 15; qrow = b * TB; NT = CTXL / 64; }
        const size_t brow = (size_t)b * TB;
        __syncthreads();
#if ATT_V2_MLA
        att::attn_body2<192, NQ, 256, 256, DM, att::NoMod2>(Q + (size_t)qrow * NQ + h * 192, KV + ((size_t)h * TROWS + brow) * 256, KPE + brow * 64, KV + ((size_t)h * TROWS + brow) * 256 + 128, O + (size_t)qrow * DM + h * 128, NT, 0, att::NoMod2{}, (char*)lds, F.tid);
#else
        if (F.wave < 4) att::attn_body<192, NQ, NKV, NKV, DM, 0, att::NoMod, PRB>(Q + (size_t)qrow * NQ + h * 192, KV + brow * NKV + h * 256, KPE + brow * 64, KV + brow * NKV + h * 256 + 128, O + (size_t)qrow * DM + h * 128, NT, 0, att::NoMod{}, (char*)lds);
        else att::attn_body<192, NQ, NKV, NKV, DM, 1, att::NoMod, PRB>(Q + (size_t)qrow * NQ + h * 192, KV + brow * NKV + h * 256, KPE + brow * 64, KV + brow * NKV + h * 256 + 128, O + (size_t)qrow * DM + h * 128, NT, 0, att::NoMod{}, (char*)lds);
#endif
    }
}
__device__ __forceinline__ void phase_na_attn(const Params& p, const Frame& F, unsigned char* lds) {
    const bf16_t* QKV = (const bf16_t*)(p.ws + WS_Q); bf16_t* O = (bf16_t*)(p.ws + WS_H);
    float* btab = (float*)(lds + att::Lds<128>::BT_OFF);
    for (int u = F.vcu; u < 1024; u += F.G) {
        const int bh = u >> 4, g = u & 15, b = bh >> 4, h = bh & 15, r0 = 4 * g;
        int lo = min(max(r0 - 4, 0), 56), hi_ = min(max(r0 - 1, 0), 56) + 8;
        const int NT = 4 + (hi_ - lo);
        const size_t brow = (size_t)b * TB; const int qrow = b * TB + CTXL + r0 * 64;
        __syncthreads();
        if (F.tid < 15 * 31) btab[F.tid] = p.na_bias[h * (15 * 31) + F.tid] * (1.0f / att::Sc<128>::SCALE);
#if ATT_V2_NA
        att::NaMod2 mod2{btab, r0, lo};
        att::attn_body2<128, 128, 128, 128, DM, att::NaMod2>(QKV + ((size_t)h * TROWS + qrow) * 128, QKV + ((size_t)(16 + h) * TROWS + brow) * 128, nullptr, QKV + ((size_t)(32 + h) * TROWS + brow) * 128, O + (size_t)qrow * DM + h * 128, NT, lo * 64, mod2, (char*)lds, F.tid);
#else
        att::NaMod mod{btab, r0, lo};
        if (F.wave < 4) att::attn_body<128, NQKV, NQKV, NQKV, DM, 0, att::NaMod>(QKV + (size_t)qrow * NQKV + h * 128, QKV + brow * NQKV + DM + h * 128, nullptr, QKV + brow * NQKV + 2 * DM + h * 128, O + (size_t)qrow * DM + h * 128, NT, lo * 64, mod, (char*)lds);
        else att::attn_body<128, NQKV, NQKV, NQKV, DM, 1, att::NaMod>(QKV + (size_t)qrow * NQKV + h * 128, QKV + brow * NQKV + DM + h * 128, nullptr, QKV + brow * NQKV + 2 * DM + h * 128, O + (size_t)qrow * DM + h * 128, NT, lo * 64, mod, (char*)lds);
#endif
    }
}

#define XB_TMO      128
#define XB_XCNT(j)  (256  + 64 * (j))
#define XB_XSUB(j)  (1280 + 64 * (j))
#define XB_XGEN(j)  (2304 + 64 * (j))
#define XB_TOP      3328
#define XB_TOPGEN   3392
#define XCD_BAR_WORDS 3456
#define XB_SPIN_CAP (1u << 18)

__device__ __forceinline__ unsigned xb_ld(unsigned* p)              { return __hip_atomic_load(p, __ATOMIC_RELAXED, __HIP_MEMORY_SCOPE_AGENT); }
__device__ __forceinline__ unsigned xb_add(unsigned* p, unsigned v) { return __hip_atomic_fetch_add(p, v, __ATOMIC_RELAXED, __HIP_MEMORY_SCOPE_AGENT); }
__device__ __forceinline__ unsigned xb_xcc_id() { return (unsigned)__builtin_amdgcn_s_getreg((3 << 11) | 20) & 0xFu; }
#define XB_SPIN(cond, bar) do { unsigned _sp = 0; while (cond) { __builtin_amdgcn_s_sleep(1); \
    if ((++_sp & 255u) == 0u) { if (xb_ld(&(bar)[XB_TMO])) break; if (_sp > XB_SPIN_CAP) { atomicAdd(&(bar)[XB_TMO], 1u); break; } } } } while (0)

struct XcdBarrier {
    unsigned* bar; unsigned x;
    volatile LAS unsigned* st;
};

__device__ __forceinline__ XcdBarrier xcd_barrier_post(unsigned* bar, volatile LAS unsigned* st) {
    XcdBarrier b; b.bar = bar; b.x = xb_xcc_id(); b.st = st;
    if (threadIdx.x == 0) (void)xb_add(&bar[XB_XCNT(b.x)], 1u);
    return b;
}
__device__ __forceinline__ void xcd_barrier_complete(unsigned* bar, unsigned x, unsigned& nloc, unsigned& nx) {
    const unsigned G = gridDim.x * gridDim.y * gridDim.z;
    unsigned sum, cnt, mine, sp = 0u;
    for (;;) {
        sum = 0u; cnt = 0u; mine = 0u;
#pragma unroll
        for (unsigned j = 0; j < 16; ++j) { const unsigned c = xb_ld(&bar[XB_XCNT(j)]); sum += c; cnt += (c > 0u) ? 1u : 0u; mine = (j == x) ? c : mine; }
        if (sum == G) break;
        __builtin_amdgcn_s_sleep(1);
        if ((++sp & 255u) == 0u) { if (xb_ld(&bar[XB_TMO])) break; if (sp > XB_SPIN_CAP) { atomicAdd(&bar[XB_TMO], 1u); break; } }
    }
    nloc = mine > 0u ? mine : 1u; nx = cnt > 0u ? cnt : 1u;
}

__device__ __forceinline__ void xcd_barrier(const XcdBarrier& b, const bool leader_thread) {
    asm volatile("s_waitcnt vmcnt(0)" ::: "memory");
    __syncthreads();
    if (leader_thread) {
        unsigned* bar = b.bar;
        __builtin_amdgcn_s_waitcnt(0);
        unsigned nloc = b.st[0], nx = b.st[1];
        if (nloc == 0u) { xcd_barrier_complete(bar, b.x, nloc, nx); b.st[0] = nloc; b.st[1] = nx; }
        const unsigned old = xb_add(&bar[XB_XSUB(b.x)], 1u);
        const unsigned gen = old / nloc;
        if (old + 1u == (gen + 1u) * nloc) {
            __builtin_amdgcn_fence(__ATOMIC_RELEASE, "agent");
            asm volatile("s_waitcnt vmcnt(0)" ::: "memory");
            const unsigned og = xb_add(&bar[XB_TOP], 1u);
            const unsigned tg = og / nx;
            if (og + 1u == (tg + 1u) * nx) xb_add(&bar[XB_TOPGEN], 1u);
            else XB_SPIN(xb_ld(&bar[XB_TOPGEN]) == tg, bar);
            __builtin_amdgcn_fence(__ATOMIC_ACQUIRE, "agent");
            xb_add(&bar[XB_XGEN(b.x)], 1u);
            asm volatile("s_waitcnt vmcnt(0)" ::: "memory");
        } else {
            XB_SPIN(xb_ld(&bar[XB_XGEN(b.x)]) == gen, bar);
            __builtin_amdgcn_fence(__ATOMIC_ACQUIRE, "agent");
            asm volatile("s_waitcnt vmcnt(0)" ::: "memory");
        }
    }
    __syncthreads();
}


constexpr int NPHASES = 18;
__device__ __forceinline__ Params load_params() {
    const __attribute__((address_space(4))) Params* q = (const __attribute__((address_space(4))) Params*)__builtin_amdgcn_kernarg_segment_ptr();
    asm volatile("" : "+s"(q)); Params r; __builtin_memcpy(&r, (const void*)q, sizeof(Params)); return r;
}
#define PL load_params()
__global__ void __launch_bounds__(NTHREADS) mega_fwd(Params p) {
    __builtin_assume(__builtin_amdgcn_workitem_id_y() == 0); __builtin_assume(__builtin_amdgcn_workitem_id_z() == 0);
    extern __shared__ __attribute__((aligned(16))) unsigned char lds_raw[];
    LAS unsigned char* lds = (LAS unsigned char*)lds_raw;
    const int wave_s = __builtin_amdgcn_readfirstlane((int)threadIdx.x >> 6);
#define MKFRAME() Frame F; { int ln_; asm volatile("v_mbcnt_lo_u32_b32 %0, -1, 0\n\tv_mbcnt_hi_u32_b32 %0, -1, %0" : "=v"(ln_)); F.lane = ln_; F.wave = wave_s; F.tid = wave_s * 64 + ln_; \
    F.G = gridDim.x; const int bx = blockIdx.x; F.vcu = (F.G % 8 == 0) ? (bx % 8) * (F.G / 8) + bx / 8 : bx; }
    cg::grid_group grid = cg::this_grid();
    unsigned char* ws = p.ws; asm volatile("" : "+s"(ws));
    const int lo = p.ph_lo, hi = p.ph_hi;
    float* XC = (float*)(ws + WS_XC); const float* MOD = (const float*)(ws + WS_MOD);
#ifndef PHASE_MASK
#define PHASE_MASK 0x3ffff
#endif
#define IN(k) (((PHASE_MASK >> (k)) & 1) && lo <= (k) && (k) < hi)
    volatile LAS unsigned* bst = (volatile LAS unsigned*)(lds + LDS_BYTES - 16);
    if (threadIdx.x < 4) bst[threadIdx.x] = 0u;
    __syncthreads();
    if (blockIdx.x == 0) { for (int i = threadIdx.x; i < 16384 / 16; i += NTHREADS) ((u32x4*)(ws + WS_CTL))[i] = (u32x4){0u, 0u, 0u, 0u}; __threadfence(); }
    if (hi - lo > 1) grid.sync();
    const XcdBarrier xbar = xcd_barrier_post((unsigned*)(ws + WS_CTL), bst);
#define GRID_BAR() do { const bool ldr_ = (wave_s == 0) && (__builtin_amdgcn_mbcnt_hi(~0u, __builtin_amdgcn_mbcnt_lo(~0u, 0u)) == 0u); xcd_barrier(xbar, ldr_); } while (0)
#define SEAM(k) do { if (IN(k) && IN((k) + 1)) GRID_BAR(); } while (0)

#ifndef DBL_MASK
#define DBL_MASK 0
#endif
#define DBL(k) ((DBL_MASK >> (k)) & 1)
#ifndef PRB_VAR
#define PRB_VAR 0
#endif
    if (IN(0)) { MKFRAME(); phase0(PL, F, lds); if (DBL(0)) { GRID_BAR(); phase0(PL, F, lds); } } SEAM(0);
    if (IN(1)) { MKFRAME(); phase_norm<true>(PL, F, 0, 0, false); } SEAM(1);
    if (IN(2)) { MKFRAME();
        pg8::Gemm g{(const bf16_t*)(ws + WS_H), (const bf16_t*)(ws + WS_WA), TROWS, NA_, DM, DM}; pg8::StaticOrder S; S.init(TROWS, NA_, F.G, (int)blockIdx.x);
        pg8::EpiBf16<0> E{(bf16_t*)(ws + WS_QA), NA_, nullptr, 0, 0};
        pg8::gemm_phase<pg8::EpiBf16<0>, pg8::StaticOrder, false>(lds, g, S, E, nullptr, F.tid);
    } SEAM(2);
    if (IN(3)) { MKFRAME(); phase_mla_norm(PL, F); } SEAM(3);
    if (IN(4)) { MKFRAME();
        { pg8::Gemm g{(const bf16_t*)(ws + WS_CQ), (const bf16_t*)(ws + WS_WUQ), TROWS, NQ, 512, 512}; pg8::StaticOrder S; S.init(TROWS, NQ, F.G, (int)blockIdx.x);
          EpiQ E{(bf16_t*)(ws + WS_Q), (const f32x2*)(ws + WS_ROPE)};
          pg8::gemm_phase<EpiQ, pg8::StaticOrder, false>(lds, g, S, E, nullptr, F.tid); }
        { pg8::Gemm g{(const bf16_t*)(ws + WS_CKV), (const bf16_t*)(ws + WS_WUKV), TROWS, NKV, 512, 512}; pg8::StaticOrder S; S.init(TROWS, NKV, F.G, (int)blockIdx.x);
          pg8::EpiBf16<0> E{(bf16_t*)(ws + WS_KV), 256, nullptr, 256, (size_t)TROWS * 256};
          pg8::gemm_phase<pg8::EpiBf16<0>, pg8::StaticOrder, false>(lds, g, S, E, nullptr, F.tid); }
    } SEAM(4);
    if (IN(5)) { MKFRAME(); phase_mla_attn(PL, F, lds_raw); if (DBL(5)) { GRID_BAR(); phase_mla_attn<PRB_VAR>(PL, F, lds_raw); } } SEAM(5);
    if (IN(6)) { MKFRAME();
        { pg8::Gemm g{(const bf16_t*)(ws + WS_H), (const bf16_t*)(ws + WS_WO0), TROWS, DM, DM, DM}; LatentOrder S; S.init(NBATCH * SEQ, DM, F.G, (int)blockIdx.x);
          EpiRes E{PL.x, PL.ctx, PL.out, XC, MOD + 2 * DM};
          pg8::gemm_phase<EpiRes, LatentOrder, false>(lds, g, S, E, nullptr, F.tid); }
        { pg8::Gemm g{(const bf16_t*)(ws + WS_H), (const bf16_t*)(ws + WS_WO0), TROWS, DM, DM / NSPLIT, DM}; CtxSplitOrder S; S.init(DM, DM, F.G, (int)blockIdx.x);
          EpiSlab E{(float*)(ws + WS_Q), S.kbytes};
          pg8::gemm_phase<EpiSlab, CtxSplitOrder, false>(lds, g, S, E, nullptr, F.tid); }
    } SEAM(6);
    if (IN(7)) { MKFRAME(); phase_norm<false, true>(PL, F, 0, 1, false, PL.ctx, MOD + 4 * 6 * DM + 2 * DM); } SEAM(7);
    if (IN(8)) { MKFRAME();
        pg8::Gemm g{(const bf16_t*)(ws + WS_H), (const bf16_t*)(ws + WS_WGU0), TROWS, NGU, DM, DM}; pg8::StaticOrder S; S.init(TROWS, NGU, F.G, (int)blockIdx.x);
        EpiSwiglu E{(bf16_t*)(ws + WS_ACT)};
        pg8::gemm_phase<EpiSwiglu, pg8::StaticOrder, false>(lds, g, S, E, nullptr, F.tid);
    } SEAM(8);
    if (IN(9)) { MKFRAME();
        { pg8::Gemm g{(const bf16_t*)(ws + WS_ACT), (const bf16_t*)(ws + WS_WD0), TROWS, DM, DFF, DFF}; LatentOrder S; S.init(NBATCH * SEQ, DM, F.G, (int)blockIdx.x);
          EpiRes E{PL.out, XC, PL.out, XC, MOD + 5 * DM};
          pg8::gemm_phase<EpiRes, LatentOrder, false>(lds, g, S, E, nullptr, F.tid); }
        { pg8::Gemm g{(const bf16_t*)(ws + WS_ACT), (const bf16_t*)(ws + WS_WD0), TROWS, DM, DFF / NSPLIT, DFF}; CtxSplitOrder S; S.init(DM, DFF, F.G, (int)blockIdx.x);
          EpiSlab E{(float*)(ws + WS_Q), S.kbytes};
          pg8::gemm_phase<EpiSlab, CtxSplitOrder, false>(lds, g, S, E, nullptr, F.tid); }
    } SEAM(9);
    if (IN(10)) { MKFRAME(); phase_norm<false, true>(PL, F, 1, 0, false, XC, MOD + 4 * 6 * DM + 5 * DM); } SEAM(10);
    if (IN(11)) { MKFRAME();
        pg8::Gemm g{(const bf16_t*)(ws + WS_H), (const bf16_t*)(ws + WS_WQKV), TROWS, NQKV, DM, DM}; pg8::StaticOrder S; S.init(TROWS, NQKV, F.G, (int)blockIdx.x);
        EpiHeads128 E{(bf16_t*)(ws + WS_Q)};
        pg8::gemm_phase<EpiHeads128, pg8::StaticOrder, false>(lds, g, S, E, nullptr, F.tid);
    } SEAM(11);
    if (IN(12)) { MKFRAME(); phase_na_attn(PL, F, lds_raw); if (DBL(12)) { GRID_BAR(); phase_na_attn(PL, F, lds_raw); } } SEAM(12);
    if (IN(13)) { MKFRAME();
        pg8::Gemm g{(const bf16_t*)(ws + WS_H), (const bf16_t*)(ws + WS_WO1), TROWS, DM, DM, DM}; LatentOrder S; S.init(NBATCH * SEQ, DM, F.G, (int)blockIdx.x);
        EpiRes E{PL.out, XC, PL.out, XC, MOD + 5 * 6 * DM + 2 * DM};
        pg8::gemm_phase<EpiRes, LatentOrder, false>(lds, g, S, E, nullptr, F.tid);
    } SEAM(13);
    if (IN(14)) { MKFRAME(); phase_norm<false>(PL, F, 1, 1, true); } SEAM(14);
    if (IN(15)) { MKFRAME();
        pg8::Gemm g{(const bf16_t*)(ws + WS_H), (const bf16_t*)(ws + WS_WGU1), TROWS, NGU, DM, DM}; LatentOrder S; S.init(NBATCH * SEQ, NGU, F.G, (int)blockIdx.x);
        EpiSwiglu E{(bf16_t*)(ws + WS_ACT)};
        pg8::gemm_phase<EpiSwiglu, LatentOrder, false>(lds, g, S, E, nullptr, F.tid);
    } SEAM(15);
    if (IN(16)) { MKFRAME();
        pg8::Gemm g{(const bf16_t*)(ws + WS_ACT), (const bf16_t*)(ws + WS_WD1), TROWS, DM, DFF, DFF}; LatentOrder S; S.init(NBATCH * SEQ, DM, F.G, (int)blockIdx.x);
        EpiRes E{PL.out, XC, PL.out, XC, MOD + 5 * 6 * DM + 5 * DM};
        pg8::gemm_phase<EpiRes, LatentOrder, false>(lds, g, S, E, nullptr, F.tid);
    } SEAM(16);
    if (IN(17)) { MKFRAME(); phase_final(PL, F); }
#undef IN
#undef SEAM
}

extern "C" void kernel_launch(void* const* d_in, const int* in_sizes, int n_in, void* d_out, int out_size, void* d_ws, size_t ws_size, hipStream_t stream) {
    static int grid = 0;
    if (grid == 0) {
        if (n_in != 22 || in_sizes[0] != NBATCH * SEQ * DM || out_size != NBATCH * SEQ * DM || ws_size < WS_END + (DBL_MASK ? (size_t)TROWS * DM * 2 : 0)) {
            fprintf(stderr, "kernel_launch: shape/workspace mismatch: n_in %d in0 %d out %d ws %zu (need %zu)\n", n_in, n_in > 0 ? in_sizes[0] : -1, out_size, ws_size, (size_t)WS_END); grid = -1; return; }
        int dev = 0, cus = 0, per_cu = 0;
        hipGetDevice(&dev); hipDeviceGetAttribute(&cus, hipDeviceAttributeMultiprocessorCount, dev);
        if (hipFuncSetAttribute((const void*)mega_fwd, hipFuncAttributeMaxDynamicSharedMemorySize, LDS_BYTES) != hipSuccess) { fprintf(stderr, "kernel_launch: hipFuncSetAttribute failed\n"); grid = -1; return; }
        if (hipOccupancyMaxActiveBlocksPerMultiprocessor(&per_cu, (const void*)mega_fwd, NTHREADS, LDS_BYTES) != hipSuccess || per_cu < 1) { fprintf(stderr, "kernel_launch: occupancy query says %d\n", per_cu); per_cu = 1; }
        (void)hipGetLastError();
        grid = cus * 1;
        fprintf(stderr, "kernel_launch: grid %d (cus %d, per_cu %d)\n", grid, cus, per_cu);
    }
    if (grid < 0) return;
    Params p{};
    const float* const* in = (const float* const*)d_in;
    p.x = in[0]; p.c = in[1]; p.ctx = in[2]; p.c_ctx = in[3]; p.ada_w = in[4]; p.ada_b = in[5]; p.norm_mix = in[6]; p.norm_ffn = in[7]; p.norm_final = in[8];
    p.w_dq = in[9]; p.q_norm = in[10]; p.w_uq = in[11]; p.w_dkv = in[12]; p.kv_norm = in[13]; p.w_ukv = in[14]; p.mla_wo = in[15];
    p.na_wqkv = in[16]; p.na_bias = in[17]; p.na_wo = in[18]; p.w_gate = in[19]; p.w_up = in[20]; p.w_down = in[21];
    p.out = (float*)d_out; p.ws = (unsigned char*)d_ws;
#if MK_ONE_LAUNCH
    p.ph_lo = 0; p.ph_hi = NPHASES;
    void* args[] = {&p};
    hipError_t e = hipLaunchCooperativeKernel((const void*)mega_fwd, dim3(grid), dim3(NTHREADS), args, LDS_BYTES, stream);
    if (e != hipSuccess) fprintf(stderr, "cooperative launch failed: %s (grid %d)\n", hipGetErrorString(e), grid);
#else
    for (int k = 0; k < NPHASES; ++k) { p.ph_lo = k; p.ph_hi = k + 1; hipLaunchKernelGGL(mega_fwd, dim3(grid), dim3(NTHREADS), LDS_BYTES, stream, p); }
#endif
}
```

```cpp
#define MK_ONE_LAUNCH 1
#include <hip/hip_runtime.h>
namespace pg8 {
#define PG8_LAS __attribute__((address_space(3)))
typedef unsigned short bf16_t;
typedef short bf16x8 __attribute__((ext_vector_type(8)));
typedef float f32x4 __attribute__((ext_vector_type(4)));
typedef unsigned u32x4 __attribute__((ext_vector_type(4)));
constexpr int BM = 256, BK = 64, HALF = 128, HTB = HALF * BK * 2  , STAGE_BYTES = 8 * HTB, NXCD = 8, WGM = 4;

__host__ __device__ __forceinline__ int lds_byte(int r, int c) { const int st = (r >> 4) * 2 + (c >> 5), rr = r & 15, cc = c & 31, ob = rr * 64 + cc * 2; return st * 1024 + (ob ^ (((ob >> 9) & 1) << 5)); }
__host__ __device__ __forceinline__ void stage_rc(int b, int& R, int& C) { const int st = b / 1024, sb = b % 1024, swz = sb ^ (((sb >> 9) & 1) << 5); R = (st >> 1) * 16 + swz / 64; C = (st & 1) * 32 + (swz % 64) / 2; }
__host__ __device__ __forceinline__ int perm32(int rho) { const int n = rho >> 4, i = rho & 15; return 8 * (i >> 2) + 4 * n + (i & 3); }

struct Unit { int pm, pn; int ko = 0; };
struct Gemm { const bf16_t* A; const bf16_t* Bt; int M, N, K; int ld; };

struct StaticOrder {
    int nM, nN, nwg, G, c;
    __host__ __device__ void init(int M, int N, int G_, int c_) { nM = M / BM; nN = N / BM; nwg = nM * nN; G = G_; c = c_; }
    __host__ __device__ bool next(int i, Unit& u) const {
        const long L = (long)i * G + c; if (L >= nwg) return false;
        int wgid = (int)L; { const int q = nwg / NXCD, r = nwg % NXCD, xcd = wgid % NXCD, off = wgid / NXCD; wgid = (xcd < r ? xcd * (q + 1) : r * (q + 1) + (xcd - r) * q) + off; }
        const int nig = WGM * nN, gid = wgid / nig, fm = gid * WGM, gsz = (nM - fm) < WGM ? (nM - fm) : WGM;
        u.pm = fm + ((wgid % nig) % gsz); u.pn = (wgid % nig) / gsz; return true;
    }
    __device__ __forceinline__ void a_ready(const Unit&) const {}
    __device__ __forceinline__ void done(const Unit&) const {}
};
struct CountedOrder : StaticOrder {
    const unsigned* ready; unsigned need; unsigned* tmo;
    __device__ __forceinline__ void a_ready(const Unit& u) const {
        if (threadIdx.x < 64) {
            const unsigned long long t0 = __builtin_amdgcn_s_memrealtime(); unsigned polls = 0;
            while ((unsigned)__builtin_amdgcn_readfirstlane(__hip_atomic_load(ready + 64 * u.pm, __ATOMIC_RELAXED, __HIP_MEMORY_SCOPE_AGENT)) < need) {
                if ((++polls & 255u) == 0u && __builtin_amdgcn_readfirstlane(__hip_atomic_load(tmo, __ATOMIC_RELAXED, __HIP_MEMORY_SCOPE_AGENT)) != 0u) break;
                if (__builtin_amdgcn_s_memrealtime() - t0 > 2000000ull) {
                    if (threadIdx.x == 0) { unsigned expect = 0u; __hip_atomic_compare_exchange_strong(tmo + 1, &expect, 0x600u | (unsigned)(u.pm & 0xff), __ATOMIC_RELAXED, __ATOMIC_RELAXED, __HIP_MEMORY_SCOPE_AGENT); __hip_atomic_store(tmo, 1u, __ATOMIC_RELAXED, __HIP_MEMORY_SCOPE_AGENT); }
                    break; }
                __builtin_amdgcn_s_sleep(2); }
            __builtin_amdgcn_fence(__ATOMIC_ACQUIRE, "agent");
            asm volatile("s_waitcnt vmcnt(0)" ::: "memory");
        }
#if !defined(BROKEN_HOOK_NO_BARRIER)
        asm volatile("" ::: "memory"); __builtin_amdgcn_s_barrier(); asm volatile("" ::: "memory");
#endif
    }
};

__device__ __forceinline__ unsigned cvt_pk_bf16(float lo, float hi) { unsigned r; asm volatile("v_cvt_pk_bf16_f32 %0, %1, %2" : "=v"(r) : "v"(lo), "v"(hi)); return r; }
typedef float f32x2 __attribute__((ext_vector_type(2)));
__device__ __forceinline__ f32x2 gelu_pk(f32x2 v) {
    const f32x2 av = __builtin_elementwise_abs(v), d = av * 0.2316418882f + 1.0f;
    f32x2 t; t.x = __builtin_amdgcn_rcpf(d.x); t.y = __builtin_amdgcn_rcpf(d.y);
    f32x2 q = t * 0.5307027145f + (-0.7265760135f); q = q * t + 0.7107068705f; q = q * t + (-0.142248368f); q = q * t + 0.127414796f; q = q * t;
    const f32x2 s = (v * v) * (-0.72134752044f);
    f32x2 e; e.x = __builtin_amdgcn_exp2f(s.x); e.y = __builtin_amdgcn_exp2f(s.y);
    const f32x2 m = v * (q * e), r = v - m;
    f32x2 o; o.x = v.x < 0.f ? m.x : r.x; o.y = v.y < 0.f ? m.y : r.y; return o;
}

struct EpiF32 {
    static constexpr bool PERM = false, AFTER_DRAIN = false;
    float* C; int ldc; const float* bias;
    __device__ __forceinline__ void operator()(const f32x4 (&acc)[2][2][4][2], const Unit& u, int wr, int wc, int fr, int fq) const {
        const int row0 = u.pm * BM + wr * 64 + fr, col0 = u.pn * BM + wc * 32 + 4 * fq;
        f32x4 bv[2][2];
#pragma unroll
        for (int bj = 0; bj < 2; ++bj)
#pragma unroll
            for (int n = 0; n < 2; ++n) bv[bj][n] = bias ? *(const f32x4*)(bias + col0 + bj * HALF + n * 16) : (f32x4){0.f, 0.f, 0.f, 0.f};
#pragma unroll
        for (int ai = 0; ai < 2; ++ai)
#pragma unroll
            for (int m = 0; m < 4; ++m) { float* rowp = C + (size_t)(row0 + ai * HALF + m * 16) * ldc + col0;
#pragma unroll
                for (int bj = 0; bj < 2; ++bj)
#pragma unroll
                    for (int n = 0; n < 2; ++n) *(f32x4*)(rowp + bj * HALF + n * 16) = acc[ai][bj][m][n] + bv[bj][n]; }
    }
};
template <int ACT  > struct EpiBf16 {
    static constexpr bool PERM = true, AFTER_DRAIN = false;
    bf16_t* O; int ldc; const float* bias; int split_cols; size_t split_stride;
    __device__ __forceinline__ void operator()(const f32x4 (&acc)[2][2][4][2], const Unit& u, int wr, int wc, int fr, int fq) const {
        const int row0 = u.pm * BM + wr * 64 + fr; int colt = u.pn * BM; bf16_t* base = O;
        if (split_cols) { const int t = colt / split_cols; base += (size_t)t * split_stride; colt -= t * split_cols; }
        const int col0 = colt + wc * 32 + 8 * fq, bcol0 = u.pn * BM + wc * 32 + 8 * fq;
        f32x4 bv[2][2];
#pragma unroll
        for (int bj = 0; bj < 2; ++bj)
#pragma unroll
            for (int n = 0; n < 2; ++n) bv[bj][n] = bias ? *(const f32x4*)(bias + bcol0 + bj * HALF + 4 * n) : (f32x4){0.f, 0.f, 0.f, 0.f};
#pragma unroll
        for (int ai = 0; ai < 2; ++ai)
#pragma unroll
            for (int m = 0; m < 4; ++m) { bf16_t* rowp = base + (size_t)(row0 + ai * HALF + m * 16) * ldc + col0;
#pragma unroll
                for (int bj = 0; bj < 2; ++bj) { f32x4 v0 = acc[ai][bj][m][0] + bv[bj][0], v1 = acc[ai][bj][m][1] + bv[bj][1];
                    if (ACT == 1) { f32x2 a = gelu_pk((f32x2){v0[0], v0[1]}), b = gelu_pk((f32x2){v0[2], v0[3]}), c = gelu_pk((f32x2){v1[0], v1[1]}), d = gelu_pk((f32x2){v1[2], v1[3]});
                        v0 = (f32x4){a.x, a.y, b.x, b.y}; v1 = (f32x4){c.x, c.y, d.x, d.y}; }
                    if (ACT == 2) {
#pragma unroll
                        for (int j = 0; j < 4; ++j) { v0[j] = 0.5f * v0[j] * (1.0f + erff(v0[j] * 0.70710678f)); v1[j] = 0.5f * v1[j] * (1.0f + erff(v1[j] * 0.70710678f)); } }
                    u32x4 w; w.x = cvt_pk_bf16(v0[0], v0[1]); w.y = cvt_pk_bf16(v0[2], v0[3]); w.z = cvt_pk_bf16(v1[0], v1[1]); w.w = cvt_pk_bf16(v1[2], v1[3]);
                    *(u32x4*)(rowp + bj * HALF) = w; } }
    }
};

template <class Epi, class Sched, bool STAMP = false, bool ALIGN_EPI = true, bool SP2 = true>
__device__ __forceinline__ void gemm_phase(PG8_LAS unsigned char* lds, const Gemm g, const Sched& S, const Epi& E, unsigned long long* stamps, const int tid_in) {
    const int tid = tid_in, wid = __builtin_amdgcn_readfirstlane(tid >> 6), lane = tid & 63, wr = wid >> 2, wc = wid & 3, fr = lane & 15, fq = lane >> 4;
    const int K = g.ld, nt = g.K / BK;
    int ts_lo = 0, ts_hi = 0, nts = 0; const unsigned long long rt_entry = STAMP ? (unsigned long long)wall_clock64() : 0ull;
#define PG8_STAMP() do { if (STAMP && wid == 0 && nts < 64) { const unsigned long long _c = (unsigned long long)clock64(); \
        ts_lo = (lane == nts) ? (int)(unsigned)_c : ts_lo; ts_hi = (lane == nts) ? (int)(unsigned)(_c >> 32) : ts_hi; ++nts; } } while (0)
    PG8_STAMP();
    unsigned voffA[2], voffB[2];
#pragma unroll
    for (int i = 0; i < 2; ++i) { int R, C; stage_rc(tid * 16 + i * 8192, R, C); const int Rb = Epi::PERM ? ((R & ~31) + perm32(R & 31)) : R;
        voffA[i] = (unsigned)(R * K + C) * 2u; voffB[i] = (unsigned)(Rb * K + C) * 2u; }
    const size_t kstep = (size_t)(BK * 2);
    const size_t hstep = (size_t)HALF * K * 2;
    const size_t tstep = 2 * hstep;
    const unsigned ldsw = (unsigned)wid * 1024u;
    const int aoff = lds_byte(wr * 64 + fr, fq * 8), boff = lds_byte(wc * 32 + fr, fq * 8);
#define PG8_SA(b, h) (((b) * 2 + (h)) * HTB)
#define PG8_SB(b, h) ((4 + (b) * 2 + (h)) * HTB)
#define PG8_STAGE(bufoff, gbase, voff) do { _Pragma("unroll") for (int _i = 0; _i < 2; ++_i) \
        __builtin_amdgcn_global_load_lds((const unsigned*)((const char*)(gbase) + (voff)[_i]), (PG8_LAS unsigned*)(lds + (bufoff) + ldsw + _i * 8192), 16, 0, 0); } while (0)
#define PG8_LDA(dst, b, h) do { _Pragma("unroll") for (int m = 0; m < 4; ++m) _Pragma("unroll") for (int k = 0; k < 2; ++k) dst[m][k] = *(const PG8_LAS bf16x8*)(lds + PG8_SA(b, h) + aoff + m * 2048 + k * 1024); } while (0)
#define PG8_LDB(dst, b, h) do { _Pragma("unroll") for (int n = 0; n < 2; ++n) _Pragma("unroll") for (int k = 0; k < 2; ++k) dst[n][k] = *(const PG8_LAS bf16x8*)(lds + PG8_SB(b, h) + boff + n * 2048 + k * 1024); } while (0)
#define PG8_MMA(ai, bj, At, Bt) do { __builtin_amdgcn_s_setprio(1); _Pragma("unroll") for (int m = 0; m < 4; ++m) _Pragma("unroll") for (int n = 0; n < 2; ++n) _Pragma("unroll") for (int k = 0; k < 2; ++k) \
        acc[ai][bj][m][n] = __builtin_amdgcn_mfma_f32_16x16x32_bf16(Bt[n][k], At[m][k], acc[ai][bj][m][n], 0, 0, 0); __builtin_amdgcn_s_setprio(0); } while (0)
#define PG8_WAIT_V(n) asm volatile("s_waitcnt vmcnt(" #n ")" ::: "memory")
#define PG8_WAIT_L(n) asm volatile("s_waitcnt lgkmcnt(" #n ")" ::: "memory")
#define PG8_BAR __builtin_amdgcn_s_barrier()
#define PG8_SCHED __builtin_amdgcn_sched_barrier(0)
    Unit cur, nxt; int ui = 0;
    if (!S.next(0, cur)) return;
    f32x4 acc[2][2][4][2];
#pragma unroll
    for (int a = 0; a < 2; ++a)
#pragma unroll
        for (int b = 0; b < 2; ++b)
#pragma unroll
            for (int m = 0; m < 4; ++m)
#pragma unroll
                for (int n = 0; n < 2; ++n) acc[a][b][m][n] = (f32x4){0.f, 0.f, 0.f, 0.f};
    bf16x8 At[4][2], B0[2][2], B1[2][2];
    const char* cA = (const char*)g.A + (size_t)cur.pm * tstep + (size_t)cur.ko; const char* cB = (const char*)g.Bt + (size_t)cur.pn * tstep + (size_t)cur.ko;
    S.a_ready(cur);
    if constexpr (SP2) {
        PG8_STAGE(PG8_SB(0, 0), cB, voffB); PG8_STAGE(PG8_SB(0, 1), cB + hstep, voffB); PG8_STAGE(PG8_SA(0, 0), cA, voffA); PG8_STAGE(PG8_SA(0, 1), cA + hstep, voffA);
        if (wr == 1) PG8_BAR;
        PG8_WAIT_V(2); PG8_BAR;
        PG8_STAGE(PG8_SB(1, 0), cB + kstep, voffB); PG8_STAGE(PG8_SA(1, 0), cA + kstep, voffA); PG8_STAGE(PG8_SB(1, 1), cB + hstep + kstep, voffB);
        PG8_WAIT_V(6); PG8_BAR;
    } else {
        PG8_STAGE(PG8_SB(0, 0), cB, voffB); PG8_STAGE(PG8_SA(0, 0), cA, voffA); PG8_STAGE(PG8_SB(0, 1), cB + hstep, voffB); PG8_STAGE(PG8_SA(0, 1), cA + hstep, voffA);
        if (wr == 1) PG8_BAR;
        PG8_WAIT_V(4); PG8_BAR;
        PG8_STAGE(PG8_SB(1, 0), cB + kstep, voffB); PG8_STAGE(PG8_SA(1, 0), cA + kstep, voffA); PG8_STAGE(PG8_SB(1, 1), cB + hstep + kstep, voffB);
        PG8_WAIT_V(6); PG8_BAR;
    }
    PG8_STAMP();
    for (;;) {
        const bool has_next = S.next(ui + 1, nxt);
        const char* nA = has_next ? (const char*)g.A + (size_t)nxt.pm * tstep + (size_t)nxt.ko : cA; const char* nB = has_next ? (const char*)g.Bt + (size_t)nxt.pn * tstep + (size_t)nxt.ko : cB;
        for (int t = 0; t < nt; t += 2) {
            const bool last = (t == nt - 2);
            const char* a1 = cA + (size_t)(t + 1) * kstep;
            const char* a2 = last ? nA : cA + (size_t)(t + 2) * kstep; const char* b2 = last ? nB : cB + (size_t)(t + 2) * kstep;
            const char* a3 = a2 + kstep; const char* b3 = b2 + kstep;
            if (last && has_next) S.a_ready(nxt);
            if constexpr (SP2) {
            PG8_LDB(B0, 0, 0); PG8_LDB(B1, 0, 1); PG8_SCHED; PG8_LDA(At, 0, 0); PG8_STAGE(PG8_SA(1, 1), a1 + hstep, voffA);
            PG8_WAIT_V(8); PG8_WAIT_L(0); PG8_BAR; PG8_MMA(0, 0, At, B0); PG8_MMA(0, 1, At, B1); PG8_BAR; PG8_SCHED;
            PG8_LDA(At, 0, 1); PG8_STAGE(PG8_SB(0, 0), b2, voffB); PG8_STAGE(PG8_SB(0, 1), b2 + hstep, voffB); PG8_STAGE(PG8_SA(0, 0), a2, voffA);
            PG8_WAIT_V(8); PG8_WAIT_L(0); PG8_BAR; PG8_MMA(1, 0, At, B0); PG8_MMA(1, 1, At, B1); PG8_BAR; PG8_SCHED;
            PG8_LDB(B0, 1, 0); PG8_LDB(B1, 1, 1); PG8_SCHED; PG8_LDA(At, 1, 0); PG8_STAGE(PG8_SA(0, 1), a2 + hstep, voffA);
            PG8_WAIT_V(8); PG8_WAIT_L(0); PG8_BAR; PG8_MMA(0, 0, At, B0); PG8_MMA(0, 1, At, B1); PG8_BAR; PG8_SCHED;
            PG8_LDA(At, 1, 1); PG8_STAGE(PG8_SB(1, 0), b3, voffB); PG8_STAGE(PG8_SB(1, 1), b3 + hstep, voffB); PG8_STAGE(PG8_SA(1, 0), a3, voffA);
            PG8_WAIT_V(8); PG8_WAIT_L(0); PG8_BAR; PG8_MMA(1, 0, At, B0); PG8_MMA(1, 1, At, B1); PG8_BAR; PG8_SCHED;
            } else {
            PG8_LDB(B0, 0, 0); PG8_SCHED; PG8_LDA(At, 0, 0); PG8_STAGE(PG8_SA(1, 1), a1 + hstep, voffA);
            PG8_WAIT_L(8); PG8_BAR; PG8_WAIT_L(0); PG8_MMA(0, 0, At, B0); PG8_BAR; PG8_SCHED;
            PG8_LDB(B1, 0, 1); PG8_STAGE(PG8_SB(0, 0), b2, voffB);
            PG8_BAR; PG8_WAIT_L(0); PG8_MMA(0, 1, At, B1); PG8_BAR;
            PG8_LDA(At, 0, 1); PG8_STAGE(PG8_SA(0, 0), a2, voffA);
            PG8_BAR; PG8_WAIT_L(0); PG8_MMA(1, 0, At, B0); PG8_BAR; PG8_SCHED;
            PG8_STAGE(PG8_SB(0, 1), b2 + hstep, voffB);
            PG8_WAIT_V(6); PG8_BAR; PG8_MMA(1, 1, At, B1); PG8_BAR;
            PG8_LDB(B0, 1, 0); PG8_SCHED; PG8_LDA(At, 1, 0); PG8_STAGE(PG8_SA(0, 1), a2 + hstep, voffA);
            PG8_WAIT_L(8); PG8_BAR; PG8_WAIT_L(0); PG8_MMA(0, 0, At, B0); PG8_BAR; PG8_SCHED;
            PG8_LDB(B1, 1, 1); PG8_STAGE(PG8_SB(1, 0), b3, voffB);
            PG8_BAR; PG8_WAIT_L(0); PG8_MMA(0, 1, At, B1); PG8_BAR;
            PG8_LDA(At, 1, 1); PG8_STAGE(PG8_SA(1, 0), a3, voffA);
            PG8_BAR; PG8_WAIT_L(0); PG8_MMA(1, 0, At, B0); PG8_BAR; PG8_SCHED;
            PG8_STAGE(PG8_SB(1, 1), b3 + hstep, voffB);
            PG8_WAIT_V(6); PG8_BAR; PG8_MMA(1, 1, At, B1); PG8_BAR;
            }
        }
        PG8_STAMP();
        if constexpr (ALIGN_EPI) { if (wr == 0) PG8_BAR; }
        if constexpr (!Epi::AFTER_DRAIN) { E(acc, cur, wr, wc, fr, fq); S.done(cur); }
        PG8_STAMP();
        if (!has_next) break;
#pragma unroll
        for (int a = 0; a < 2; ++a)
#pragma unroll
            for (int b = 0; b < 2; ++b)
#pragma unroll
                for (int m = 0; m < 4; ++m)
#pragma unroll
                    for (int n = 0; n < 2; ++n) acc[a][b][m][n] = (f32x4){0.f, 0.f, 0.f, 0.f};
        cur = nxt; cA = nA; cB = nB; ++ui;
        if constexpr (ALIGN_EPI) { if (wr == 1) PG8_BAR; }
    }
    PG8_WAIT_V(0);
    if constexpr (!ALIGN_EPI) { if (wr == 0) PG8_BAR; }
    PG8_BAR;
    if constexpr (Epi::AFTER_DRAIN) { E.fused(acc, cur, wr, wc, fr, fq, lds, wid, lane); S.done(cur); }
    PG8_STAMP();
    if (STAMP && wid == 0) { stamps[lane] = lane < nts ? (((unsigned long long)(unsigned)ts_hi << 32) | (unsigned)ts_lo) : 0ull;
        if (lane == 62) stamps[62] = rt_entry; if (lane == 63) stamps[63] = (unsigned long long)wall_clock64(); }
#undef PG8_STAMP
#undef PG8_SA
#undef PG8_SB
#undef PG8_STAGE
#undef PG8_LDA
#undef PG8_LDB
#undef PG8_MMA
#undef PG8_WAIT_V
#undef PG8_WAIT_L
#undef PG8_BAR
#undef PG8_SCHED
}
}


#include <hip/hip_cooperative_groups.h>
#include <cstdio>
#include <utility>
namespace cg = cooperative_groups;

#ifndef MK_ONE_LAUNCH
#define MK_ONE_LAUNCH 1
#endif

#define LAS __attribute__((address_space(3)))
typedef unsigned short bf16_t;
typedef short bf16x8 __attribute__((ext_vector_type(8)));
typedef short s16x4 __attribute__((ext_vector_type(4)));
typedef float f32x4 __attribute__((ext_vector_type(4)));
typedef float f32x2 __attribute__((ext_vector_type(2)));
typedef float f32x8 __attribute__((ext_vector_type(8)));
typedef float f32x16 __attribute__((ext_vector_type(16)));
typedef unsigned u32x4 __attribute__((ext_vector_type(4)));
typedef unsigned u32x2 __attribute__((ext_vector_type(2)));

constexpr int DM = 2048, NBATCH = 4, SEQ = 4096, CTXL = 256, TB = SEQ + CTXL  , TROWS = NBATCH * TB  ;
constexpr int NH = 16, DFF = 5632, NA_ = 1280  , NQ = 3072, NKV = 4096, NQKV = 6144, NGU = 2 * DFF;
constexpr int NWAVES = 8, NTHREADS = 512;
constexpr float EPS = 1e-6f;

constexpr size_t al256(size_t x) { return (x + 255) / 256 * 256; }
constexpr size_t WS_WA = 0;
constexpr size_t WS_WUQ = WS_WA + al256((size_t)NA_ * DM * 2);
constexpr size_t WS_WUKV = WS_WUQ + al256((size_t)NQ * 512 * 2);
constexpr size_t WS_WO0 = WS_WUKV + al256((size_t)NKV * 512 * 2);
constexpr size_t WS_WQKV = WS_WO0 + al256((size_t)DM * DM * 2);
constexpr size_t WS_WO1 = WS_WQKV + al256((size_t)NQKV * DM * 2);
constexpr size_t WS_WGU0 = WS_WO1 + al256((size_t)DM * DM * 2);
constexpr size_t WS_WGU1 = WS_WGU0 + al256((size_t)NGU * DM * 2);
constexpr size_t WS_WD0 = WS_WGU1 + al256((size_t)NGU * DM * 2);
constexpr size_t WS_WD1 = WS_WD0 + al256((size_t)DM * DFF * 2);
constexpr size_t WS_MOD = WS_WD1 + al256((size_t)DM * DFF * 2);
constexpr size_t WS_ROPE = WS_MOD + al256((size_t)2 * 5 * 6 * DM * 4);
constexpr size_t WS_CTL = WS_ROPE + al256(64 * 16 * 8);
constexpr size_t WS_XC = WS_CTL + 16384;
constexpr size_t WS_H = WS_XC + al256((size_t)NBATCH * CTXL * DM * 4);
constexpr size_t WS_Q = WS_H + al256((size_t)TROWS * DM * 2);
constexpr size_t WS_KV = WS_Q + al256((size_t)TROWS * NQ * 2);
constexpr size_t WS_ACT = WS_KV + al256((size_t)TROWS * NKV * 2);
constexpr size_t WS_QA = WS_ACT;
constexpr size_t WS_CQ = WS_QA + al256((size_t)TROWS * NA_ * 4);
constexpr size_t WS_CKV = WS_CQ + al256((size_t)TROWS * 512 * 2);
constexpr size_t WS_KPE = WS_CKV + al256((size_t)TROWS * 512 * 2);
constexpr size_t WS_END = WS_ACT + al256((size_t)TROWS * DFF * 2);
static_assert(WS_KPE + (size_t)TROWS * 64 * 2 <= WS_END, "alias region");
static_assert((size_t)TROWS * NQKV * 2 <= WS_ACT - WS_Q, "qkv alias");

constexpr int LDS_BYTES = 131072 + 4096;

struct Params {
    const float *x, *c, *ctx, *c_ctx, *ada_w, *ada_b, *norm_mix, *norm_ffn, *norm_final;
    const float *w_dq, *q_norm, *w_uq, *w_dkv, *kv_norm, *w_ukv, *mla_wo, *na_wqkv, *na_bias, *na_wo, *w_gate, *w_up, *w_down;
    float* out; unsigned char* ws;
    int ph_lo, ph_hi;
};

struct Frame { int tid, lane, wave, G, vcu; };

__device__ __forceinline__ unsigned pk2(float lo, float hi) { unsigned r; asm volatile("v_cvt_pk_bf16_f32 %0, %1, %2" : "=v"(r) : "v"(lo), "v"(hi)); return r; }
__device__ __forceinline__ float wave_sum(float v) {
#pragma unroll
    for (int o = 1; o < 64; o <<= 1) v += __shfl_xor(v, o);
    return v;
}
__device__ __forceinline__ float silu_f(float v) { return v / (1.0f + __expf(-v)); }
__device__ __forceinline__ int rope_perm(int d) { return d < 16 ? 2 * d : d < 32 ? 2 * (d - 16) + 1 : d < 48 ? 2 * (d - 16) : 2 * (d - 32) + 1; }

template <int KIND> __device__ __forceinline__ int dst_row(int n) {
    if (KIND == 0) return n;
    if (KIND == 1) return n < 512 ? 512 + n : 1024 + rope_perm(n - 512);
    if (KIND == 2) { const int h = n / 192, d = n - h * 192; return h * 192 + (d < 128 ? d : 128 + rope_perm(d - 128)); }
    if (KIND == 3) return (n >> 7) * 256 + (n & 127);
    return (n >> 7) * 256 + 128 + (n & 127);
}
template <int KIND>
__device__ __forceinline__ void transpose_item(const float* __restrict__ W, int K, int N, bf16_t* __restrict__ WT, LAS float* scr, int item, int lane) {
    const int nblk = N / 32, kb = item / nblk, nb = item - kb * nblk, k0 = 64 * kb, n0 = 32 * nb;
    float tv[32];
#pragma unroll
    for (int i = 0; i < 32; ++i) { const int kk = 2 * i + (lane >> 5); tv[i] = W[(size_t)(k0 + kk) * N + n0 + (lane & 31)]; }
#pragma unroll
    for (int i = 0; i < 32; ++i) { const int kk = 2 * i + (lane >> 5); scr[kk * 33 + (lane & 31)] = tv[i]; }
    asm volatile("s_waitcnt lgkmcnt(0)" ::: "memory");
    const int c = lane & 7;
#pragma unroll
    for (int j = 0; j < 4; ++j) { const int n = (lane >> 3) + 8 * j; const LAS float* s = scr + (8 * c) * 33 + n;
        u32x4 o; o.x = pk2(s[0 * 33], s[1 * 33]); o.y = pk2(s[2 * 33], s[3 * 33]); o.z = pk2(s[4 * 33], s[5 * 33]); o.w = pk2(s[6 * 33], s[7 * 33]);
        *(u32x4*)(WT + (size_t)dst_row<KIND>(n0 + n) * K + k0 + 8 * c) = o; }
    asm volatile("s_waitcnt lgkmcnt(0)" ::: "memory");
}

__device__ __forceinline__ void phase0(const Params& p, const Frame& F, LAS unsigned char* lds) {
    unsigned char* ws = p.ws;
    { const int gt = blockIdx.x * NTHREADS + F.tid;
      if (gt < 64 * 16) { const int pos = gt >> 4, f = gt & 15; const float inv = powf(10000.0f, -(float)f / 16.0f); const float ang = (float)pos * inv;
          const double a = (double)ang; const double n = rint(a * 0.15915494309189535); const float r = (float)(a - n * 6.283185307179586);
          ((f32x2*)(ws + WS_ROPE))[gt] = (f32x2){__cosf(r), __sinf(r)}; } }
    { bf16_t* wa = (bf16_t*)(ws + WS_WA) + (size_t)1088 * DM; const int n16 = 192 * DM / 8;
      for (int i = blockIdx.x * NTHREADS + F.tid; i < n16; i += F.G * NTHREADS) ((u32x4*)wa)[i] = (u32x4){0u, 0u, 0u, 0u}; }
    if ((int)blockIdx.x < 192) {
        LAS float* sc = (LAS float*)lds;
        LAS float* red = (LAS float*)(lds + 5 * 2048 * 4);
        for (int i = F.tid; i < 5 * 2048; i += NTHREADS) { const int r = i >> 11, k = i & 2047; const float v = r < 4 ? p.c[r * DM + k] : p.c_ctx[k]; sc[i] = silu_f(v); }
        __syncthreads();
        const int item = blockIdx.x, l = item / 96, nb = item % 96, n = nb * 128 + F.lane * 2;
        const float* W = p.ada_w + (size_t)l * DM * (6 * DM) + n;
        float a0[5] = {0.f, 0.f, 0.f, 0.f, 0.f}, a1[5] = {0.f, 0.f, 0.f, 0.f, 0.f};
        const int kbeg = F.wave * 256;
        for (int k = kbeg; k < kbeg + 256; k += 8) {
            f32x2 w[8];
#pragma unroll
            for (int u = 0; u < 8; ++u) w[u] = *(const f32x2*)(W + (size_t)(k + u) * (6 * DM));
#pragma unroll
            for (int r = 0; r < 5; ++r) {
                const f32x4 s0 = *(const LAS f32x4*)(sc + r * 2048 + k), s1 = *(const LAS f32x4*)(sc + r * 2048 + k + 4);
                a0[r] += s0.x * w[0].x + s0.y * w[1].x + s0.z * w[2].x + s0.w * w[3].x + s1.x * w[4].x + s1.y * w[5].x + s1.z * w[6].x + s1.w * w[7].x;
                a1[r] += s0.x * w[0].y + s0.y * w[1].y + s0.z * w[2].y + s0.w * w[3].y + s1.x * w[4].y + s1.y * w[5].y + s1.z * w[6].y + s1.w * w[7].y;
            }
        }
#pragma unroll
        for (int r = 0; r < 5; ++r) { red[(F.wave * 5 + r) * 128 + F.lane * 2] = a0[r]; red[(F.wave * 5 + r) * 128 + F.lane * 2 + 1] = a1[r]; }
        __syncthreads();
        for (int i = F.tid; i < 5 * 128; i += NTHREADS) { const int r = i >> 7, cc = i & 127; float s = 0.f;
#pragma unroll
            for (int w = 0; w < 8; ++w) s += red[(w * 5 + r) * 128 + cc];
            const int nn = nb * 128 + cc; ((float*)(ws + WS_MOD))[(size_t)(l * 5 + r) * (6 * DM) + nn] = s + p.ada_b[l * 6 * DM + nn]; }
        __syncthreads();
    }
    LAS float* scr = (LAS float*)(lds + F.wave * 16384);
    const int gw = F.vcu * NWAVES + F.wave, NGW = F.G * NWAVES;
    constexpr int I0 = 32 * 16, I1 = 32 * 18, I2 = 8 * 96, I3 = 8 * 128, I4 = 32 * 64, I5 = 32 * 192, I6 = 32 * 64, IG = 32 * 176, ID = 88 * 64;
    constexpr int NITEMS = I0 + I1 + I2 + I3 + I4 + I5 + I6 + 4 * IG + 2 * ID;
    for (int it = gw; it < NITEMS; it += NGW) {
        int r = it;
        if (r < I0) { transpose_item<0>(p.w_dq, DM, 512, (bf16_t*)(ws + WS_WA), scr, r, F.lane); continue; } r -= I0;
        if (r < I1) { transpose_item<1>(p.w_dkv, DM, 576, (bf16_t*)(ws + WS_WA), scr, r, F.lane); continue; } r -= I1;
        if (r < I2) { transpose_item<2>(p.w_uq, 512, NQ, (bf16_t*)(ws + WS_WUQ), scr, r, F.lane); continue; } r -= I2;
        if (r < I3) { transpose_item<0>(p.w_ukv, 512, NKV, (bf16_t*)(ws + WS_WUKV), scr, r, F.lane); continue; } r -= I3;
        if (r < I4) { transpose_item<0>(p.mla_wo, DM, DM, (bf16_t*)(ws + WS_WO0), scr, r, F.lane); continue; } r -= I4;
        if (r < I5) { transpose_item<0>(p.na_wqkv, DM, NQKV, (bf16_t*)(ws + WS_WQKV), scr, r, F.lane); continue; } r -= I5;
        if (r < I6) { transpose_item<0>(p.na_wo, DM, DM, (bf16_t*)(ws + WS_WO1), scr, r, F.lane); continue; } r -= I6;
        if (r < IG) { transpose_item<3>(p.w_gate, DM, DFF, (bf16_t*)(ws + WS_WGU0), scr, r, F.lane); continue; } r -= IG;
        if (r < IG) { transpose_item<4>(p.w_up, DM, DFF, (bf16_t*)(ws + WS_WGU0), scr, r, F.lane); continue; } r -= IG;
        if (r < IG) { transpose_item<3>(p.w_gate + (size_t)DM * DFF, DM, DFF, (bf16_t*)(ws + WS_WGU1), scr, r, F.lane); continue; } r -= IG;
        if (r < IG) { transpose_item<4>(p.w_up + (size_t)DM * DFF, DM, DFF, (bf16_t*)(ws + WS_WGU1), scr, r, F.lane); continue; } r -= IG;
        if (r < ID) { transpose_item<0>(p.w_down, DFF, DM, (bf16_t*)(ws + WS_WD0), scr, r, F.lane); continue; } r -= ID;
        transpose_item<0>(p.w_down + (size_t)DFF * DM, DFF, DM, (bf16_t*)(ws + WS_WD1), scr, r, F.lane);
    }
}

constexpr int NSPLIT = 4;
template <bool FROM_INPUT, bool PEND = false>
__device__ __forceinline__ void phase_norm(const Params& p, const Frame& F, int layer, int which, bool skip_ctx, const float* ctx_src = nullptr, const float* pend_gate = nullptr) {
    const int gw = F.vcu * NWAVES + F.wave, NGW = F.G * NWAVES;
    const float* gn = (which ? p.norm_ffn : p.norm_mix) + layer * DM;
    const float* mod = (const float*)(p.ws + WS_MOD) + (size_t)layer * 5 * 6 * DM;
    bf16_t* Hb = (bf16_t*)(p.ws + WS_H);
    for (int row = gw; row < TROWS; row += NGW) {
        const int b = row / TB, rb = row - b * TB; const bool isctx = rb < CTXL;
        if (isctx && skip_ctx) continue;
        const float* src;
        if (FROM_INPUT) src = isctx ? p.ctx + (size_t)(b * CTXL + rb) * DM : p.x + (size_t)(b * SEQ + rb - CTXL) * DM;
        else src = isctx ? (const float*)(p.ws + WS_XC) + (size_t)(b * CTXL + rb) * DM : p.out + (size_t)(b * SEQ + rb - CTXL) * DM;
        const float* mr = mod + (size_t)(isctx ? 4 : b) * 6 * DM + (which ? 3 : 0) * DM;
        f32x4 v[8]; float ss = 0.f;
        if (PEND && isctx) {
            const size_t ro = (size_t)(b * CTXL + rb) * DM; const float* sl = (const float*)(p.ws + WS_Q) + ro; float* xc = (float*)(p.ws + WS_XC) + ro;
#pragma unroll
            for (int j = 0; j < 8; ++j) { const int c = 4 * F.lane + 256 * j; f32x4 a = *(const f32x4*)(sl + c);
#pragma unroll
                for (int q = 1; q < NSPLIT; ++q) a += *(const f32x4*)(sl + (size_t)q * NBATCH * CTXL * DM + c);
                v[j] = *(const f32x4*)(ctx_src + ro + c) + *(const f32x4*)(pend_gate + c) * a; *(f32x4*)(xc + c) = v[j];
                ss += (v[j].x * v[j].x + v[j].y * v[j].y) + (v[j].z * v[j].z + v[j].w * v[j].w); }
        } else {
#pragma unroll
        for (int j = 0; j < 8; ++j) { v[j] = *(const f32x4*)(src + 4 * F.lane + 256 * j); ss += (v[j].x * v[j].x + v[j].y * v[j].y) + (v[j].z * v[j].z + v[j].w * v[j].w); }
        }
        const float rstd = rsqrtf(wave_sum(ss) * (1.0f / DM) + EPS);
#pragma unroll
        for (int j = 0; j < 8; ++j) { const int c = 4 * F.lane + 256 * j;
            const f32x4 g = *(const f32x4*)(gn + c), sh = *(const f32x4*)(mr + c), sc = *(const f32x4*)(mr + DM + c);
            const f32x4 y = (v[j] * rstd * g) * (sc + 1.0f) + sh;
            u32x2 o; o.x = pk2(y.x, y.y); o.y = pk2(y.z, y.w);
            *(u32x2*)(Hb + (size_t)row * DM + c) = o; }
    }
}

__device__ __forceinline__ void phase_mla_norm(const Params& p, const Frame& F) {
    const int gw = F.vcu * NWAVES + F.wave, NGW = F.G * NWAVES;
    const bf16_t* QA = (const bf16_t*)(p.ws + WS_QA);
    bf16_t* CQ = (bf16_t*)(p.ws + WS_CQ); bf16_t* CKV = (bf16_t*)(p.ws + WS_CKV); bf16_t* KPE = (bf16_t*)(p.ws + WS_KPE);
    const f32x2* rope = (const f32x2*)(p.ws + WS_ROPE);
    for (int row = gw; row < TROWS; row += NGW) {
        const int b = row / TB, rb = row - b * TB; const bool isctx = rb < CTXL;
        const bf16_t* src = QA + (size_t)row * NA_;
        const u32x4 qw = *(const u32x4*)(src + 8 * F.lane), kw = *(const u32x4*)(src + 512 + 8 * F.lane);
        const f32x4 q0 = {__uint_as_float(qw.x << 16), __uint_as_float(qw.x & 0xffff0000u), __uint_as_float(qw.y << 16), __uint_as_float(qw.y & 0xffff0000u)};
        const f32x4 q1 = {__uint_as_float(qw.z << 16), __uint_as_float(qw.z & 0xffff0000u), __uint_as_float(qw.w << 16), __uint_as_float(qw.w & 0xffff0000u)};
        const f32x4 k0 = {__uint_as_float(kw.x << 16), __uint_as_float(kw.x & 0xffff0000u), __uint_as_float(kw.y << 16), __uint_as_float(kw.y & 0xffff0000u)};
        const f32x4 k1 = {__uint_as_float(kw.z << 16), __uint_as_float(kw.z & 0xffff0000u), __uint_as_float(kw.w << 16), __uint_as_float(kw.w & 0xffff0000u)};
        const float pe = __uint_as_float((unsigned)src[1024 + F.lane] << 16);
        float sq = (q0.x * q0.x + q0.y * q0.y) + (q0.z * q0.z + q0.w * q0.w) + (q1.x * q1.x + q1.y * q1.y) + (q1.z * q1.z + q1.w * q1.w);
        float sk = (k0.x * k0.x + k0.y * k0.y) + (k0.z * k0.z + k0.w * k0.w) + (k1.x * k1.x + k1.y * k1.y) + (k1.z * k1.z + k1.w * k1.w);
        const float rq = rsqrtf(wave_sum(sq) * (1.0f / 512.0f) + EPS), rk = rsqrtf(wave_sum(sk) * (1.0f / 512.0f) + EPS);
        const f32x4 gq0 = *(const f32x4*)(p.q_norm + 8 * F.lane), gq1 = *(const f32x4*)(p.q_norm + 8 * F.lane + 4);
        const f32x4 gk0 = *(const f32x4*)(p.kv_norm + 8 * F.lane), gk1 = *(const f32x4*)(p.kv_norm + 8 * F.lane + 4);
        const f32x4 a0 = q0 * rq * gq0, a1 = q1 * rq * gq1, c0 = k0 * rk * gk0, c1 = k1 * rk * gk1;
        u32x4 o; o.x = pk2(a0.x, a0.y); o.y = pk2(a0.z, a0.w); o.z = pk2(a1.x, a1.y); o.w = pk2(a1.z, a1.w);
        *(u32x4*)(CQ + (size_t)row * 512 + 8 * F.lane) = o;
        o.x = pk2(c0.x, c0.y); o.y = pk2(c0.z, c0.w); o.z = pk2(c1.x, c1.y); o.w = pk2(c1.z, c1.w);
        *(u32x4*)(CKV + (size_t)row * 512 + 8 * F.lane) = o;
        const float other = __shfl_xor(pe, 1);
        float r = pe;
        if (!isctx) { const int s = rb - CTXL, gr = s >> 6, gc = s & 63; const int i = F.lane >> 1, f = i & 15; const int pos = i < 16 ? gr : gc;
            const f32x2 cs = rope[pos * 16 + f];
            r = (F.lane & 1) ? pe * cs.x + other * cs.y : pe * cs.x - other * cs.y; }
        const float rn = __shfl_xor(r, 1);
        if (!(F.lane & 1)) *(unsigned*)(KPE + (size_t)row * 64 + F.lane) = pk2(r, rn);
    }
}

__device__ __forceinline__ void phase_final(const Params& p, const Frame& F) {
    const int gw = F.vcu * NWAVES + F.wave, NGW = F.G * NWAVES; constexpr int NR = NBATCH * SEQ;
    f32x4 v[8];
    if (gw < NR) {
#pragma unroll
        for (int j = 0; j < 8; ++j) v[j] = *(const f32x4*)(p.out + (size_t)gw * DM + 4 * F.lane + 256 * j); }
    for (int row = gw; row < NR; row += NGW) {
        float* src = p.out + (size_t)row * DM; const int nrow = row + NGW; f32x4 nv[8];
        if (nrow < NR) {
#pragma unroll
            for (int j = 0; j < 8; ++j) nv[j] = *(const f32x4*)(p.out + (size_t)nrow * DM + 4 * F.lane + 256 * j); }
        float ss = 0.f;
#pragma unroll
        for (int j = 0; j < 8; ++j) ss += (v[j].x * v[j].x + v[j].y * v[j].y) + (v[j].z * v[j].z + v[j].w * v[j].w);
        const float rstd = rsqrtf(wave_sum(ss) * (1.0f / DM) + EPS);
#pragma unroll
        for (int j = 0; j < 8; ++j) { const int c = 4 * F.lane + 256 * j; const f32x4 g = *(const f32x4*)(p.norm_final + c); *(f32x4*)(src + c) = v[j] * rstd * g; }
        if (nrow < NR) {
#pragma unroll
            for (int j = 0; j < 8; ++j) v[j] = nv[j]; }
    }
}

using pg8::Unit; using pg8::HALF; using pg8::BM;
struct EpiQ {
    static constexpr bool PERM = true, AFTER_DRAIN = false;
    bf16_t* O; const f32x2* rope;
    __device__ __forceinline__ void operator()(const f32x4 (&acc)[2][2][4][2], const Unit& u, int wr, int wc, int fr, int fq) const {
        const int b = u.pm / 17, j = u.pm - b * 17; const bool latent = j > 0;
#pragma unroll
        for (int bj = 0; bj < 2; ++bj) {
            const int c32 = u.pn * BM + bj * HALF + wc * 32; const int hd = c32 / 192, off = c32 - hd * 192; const bool isrope = (off >= 128) && latent; const bool colrope = off == 160;
#pragma unroll
            for (int ai = 0; ai < 2; ++ai)
#pragma unroll
                for (int m = 0; m < 4; ++m) {
                    const int row = u.pm * BM + ai * HALF + wr * 64 + m * 16 + fr;
                    f32x4 v0 = acc[ai][bj][m][0], v1 = acc[ai][bj][m][1];
                    if (isrope) { const int gr = 4 * (j - 1) + 2 * ai + wr, gc = 16 * m + fr; const int pos = colrope ? gc : gr;
                        const f32x4 t0 = *(const f32x4*)(rope + pos * 16 + 4 * fq), t1 = *(const f32x4*)(rope + pos * 16 + 4 * fq + 2);
                        f32x4 w0, w1;
                        w0.x = v0.x * t0.x - v0.y * t0.y; w0.y = v0.y * t0.x + v0.x * t0.y; w0.z = v0.z * t0.z - v0.w * t0.w; w0.w = v0.w * t0.z + v0.z * t0.w;
                        w1.x = v1.x * t1.x - v1.y * t1.y; w1.y = v1.y * t1.x + v1.x * t1.y; w1.z = v1.z * t1.z - v1.w * t1.w; w1.w = v1.w * t1.z + v1.z * t1.w;
                        v0 = w0; v1 = w1; }
                    u32x4 w; w.x = pk2(v0[0], v0[1]); w.y = pk2(v0[2], v0[3]); w.z = pk2(v1[0], v1[1]); w.w = pk2(v1[2], v1[3]);
                    *(u32x4*)(O + (size_t)row * NQ + c32 + 8 * fq) = w; }
        }
    }
};
struct EpiRes {
    static constexpr bool PERM = false, AFTER_DRAIN = false;
    const float *src_lat, *src_ctx; float *dst_lat, *dst_ctx; const float* gate;
    __device__ __forceinline__ void operator()(const f32x4 (&acc)[2][2][4][2], const Unit& u, int wr, int wc, int fr, int fq) const {
        const int b = u.pm / 17, j = u.pm - b * 17; const bool isctx = j == 0;
        const size_t rbase = isctx ? (size_t)b * CTXL : (size_t)b * SEQ + (size_t)(j - 1) * 256;
        const float* sp = (isctx ? src_ctx : src_lat) + rbase * DM; float* dp = (isctx ? dst_ctx : dst_lat) + rbase * DM;
        const float* g = gate + (size_t)(isctx ? 4 : b) * 6 * DM;
        const int col0 = u.pn * BM + wc * 32 + 4 * fq;
        f32x4 gv[2][2];
#pragma unroll
        for (int bj = 0; bj < 2; ++bj)
#pragma unroll
            for (int n = 0; n < 2; ++n) gv[bj][n] = *(const f32x4*)(g + col0 + bj * HALF + n * 16);
#pragma unroll
        for (int ai = 0; ai < 2; ++ai)
#pragma unroll
            for (int m = 0; m < 4; ++m) { const size_t off = (size_t)(ai * HALF + wr * 64 + m * 16 + fr) * DM + col0;
#pragma unroll
                for (int bj = 0; bj < 2; ++bj)
#pragma unroll
                    for (int n = 0; n < 2; ++n) { const f32x4 r = *(const f32x4*)(sp + off + bj * HALF + n * 16); *(f32x4*)(dp + off + bj * HALF + n * 16) = r + gv[bj][n] * acc[ai][bj][m][n]; }
                asm volatile("" ::: "memory"); }
    }
};
struct EpiHeads128 {
    static constexpr bool PERM = true, AFTER_DRAIN = false;
    bf16_t* O;
    __device__ __forceinline__ void operator()(const f32x4 (&acc)[2][2][4][2], const Unit& u, int wr, int wc, int fr, int fq) const {
#pragma unroll
        for (int ai = 0; ai < 2; ++ai)
#pragma unroll
            for (int m = 0; m < 4; ++m) { const size_t row = (size_t)(u.pm * BM + ai * HALF + wr * 64 + m * 16 + fr);
#pragma unroll
                for (int bj = 0; bj < 2; ++bj) { const f32x4 v0 = acc[ai][bj][m][0], v1 = acc[ai][bj][m][1];
                    u32x4 w; w.x = pk2(v0[0], v0[1]); w.y = pk2(v0[2], v0[3]); w.z = pk2(v1[0], v1[1]); w.w = pk2(v1[2], v1[3]);
                    *(u32x4*)(O + ((size_t)(2 * u.pn + bj) * TROWS + row) * 128 + wc * 32 + 8 * fq) = w; } }
    }
};
struct EpiSwiglu {
    static constexpr bool PERM = true, AFTER_DRAIN = false;
    bf16_t* O;
    __device__ __forceinline__ void operator()(const f32x4 (&acc)[2][2][4][2], const Unit& u, int wr, int wc, int fr, int fq) const {
        const int col0 = u.pn * HALF + wc * 32 + 8 * fq;
#pragma unroll
        for (int ai = 0; ai < 2; ++ai)
#pragma unroll
            for (int m = 0; m < 4; ++m) { const int row = u.pm * BM + ai * HALF + wr * 64 + m * 16 + fr;
                f32x4 r0, r1;
#pragma unroll
                for (int e = 0; e < 4; ++e) { const float g0 = acc[ai][0][m][0][e], g1 = acc[ai][0][m][1][e];
                    r0[e] = g0 * __builtin_amdgcn_rcpf(1.0f + __expf(-g0)) * acc[ai][1][m][0][e]; r1[e] = g1 * __builtin_amdgcn_rcpf(1.0f + __expf(-g1)) * acc[ai][1][m][1][e]; }
                u32x4 w; w.x = pk2(r0[0], r0[1]); w.y = pk2(r0[2], r0[3]); w.z = pk2(r1[0], r1[1]); w.w = pk2(r1[2], r1[3]);
                *(u32x4*)(O + (size_t)row * DFF + col0) = w; }
    }
};
struct LatentOrder : pg8::StaticOrder {
    __device__ bool next(int i, Unit& u) const { if (!pg8::StaticOrder::next(i, u)) return false; u.pm = u.pm + (u.pm >> 4) + 1; return true; }
};

struct CtxSplitOrder {
    int nN, G, c, kbytes;
    __device__ void init(int N, int K, int G_, int c_) { nN = N / BM; G = G_; c = c_; kbytes = (K / NSPLIT) * 2; }
    __device__ bool next(int i, Unit& u) const { const int L = i * G + c; if (L >= 4 * nN * NSPLIT) return false; const int ks = L % NSPLIT, t = L / NSPLIT; u.pm = (t / nN) * 17; u.pn = t % nN; u.ko = ks * kbytes; return true; }
    __device__ __forceinline__ void a_ready(const Unit&) const {}
    __device__ __forceinline__ void done(const Unit&) const {}
};
struct EpiSlab {
    static constexpr bool PERM = false, AFTER_DRAIN = false;
    float* slab; int kbytes;
    __device__ __forceinline__ void operator()(const f32x4 (&acc)[2][2][4][2], const Unit& u, int wr, int wc, int fr, int fq) const {
        const int b = u.pm / 17, ks = u.ko / kbytes;
        float* dp = slab + ((size_t)ks * NBATCH * CTXL + (size_t)b * CTXL) * DM; const int col0 = u.pn * BM + wc * 32 + 4 * fq;
#pragma unroll
        for (int ai = 0; ai < 2; ++ai)
#pragma unroll
            for (int m = 0; m < 4; ++m) { const size_t off = (size_t)(ai * HALF + wr * 64 + m * 16 + fr) * DM + col0;
#pragma unroll
                for (int bj = 0; bj < 2; ++bj)
#pragma unroll
                    for (int n = 0; n < 2; ++n) *(f32x4*)(dp + off + bj * HALF + n * 16) = acc[ai][bj][m][n]; }
    }
};

namespace att {
#define SBAR() __builtin_amdgcn_sched_barrier(0)
constexpr int QBLK = 32, KVBLK = 64, DV = 128;
constexpr float THR = 8.f;
template <int DQK> struct Sc { static constexpr float SCALE = DQK == 192 ? 0.07216878364870322f : 0.08838834764831845f; };
__device__ __forceinline__ int crow(int r, int hi) { return (r & 3) + 8 * (r >> 2) + 4 * hi; }
template <int DQK> __device__ __forceinline__ int kswz_x(int row) { return DQK == 192 ? (((row >> 1) & 7) << 4) : ((row & 7) << 4); }
template <int DQK> __device__ __forceinline__ int kswz(int row, int colB) { return row * (DQK * 2) + (colB ^ kswz_x<DQK>(row)); }

template <int DQK>
__device__ __forceinline__ void partialSM(f32x16& p0, f32x16& p1, float& m_reg, float& mn, float& alpha) {
    constexpr float SCALE = Sc<DQK>::SCALE; constexpr float C = SCALE * 1.4426950408889634f;
    float pmax = p0[0];
#pragma unroll
    for (int r = 1; r < 16; ++r) pmax = fmaxf(pmax, p0[r]);
#pragma unroll
    for (int r = 0; r < 16; ++r) pmax = fmaxf(pmax, p1[r]);
    { auto rr = __builtin_amdgcn_permlane32_swap(__float_as_uint(pmax), __float_as_uint(pmax), false, false);
      pmax = fmaxf(__uint_as_float(rr[0]), __uint_as_float(rr[1])); }
    if (__builtin_expect(__all(pmax - m_reg <= THR / SCALE), 1)) { mn = m_reg; alpha = 1.f; }
    else { mn = fmaxf(m_reg, pmax); alpha = __builtin_amdgcn_exp2f((m_reg - mn) * C); m_reg = mn; }
    const float mnC = -mn * C;
#pragma unroll
    for (int r = 0; r < 16; ++r) p0[r] = fmaf(p0[r], C, mnC);
#pragma unroll
    for (int r = 0; r < 16; ++r) p1[r] = fmaf(p1[r], C, mnC);
#pragma unroll
    for (int r = 0; r < 16; ++r) p0[r] = __builtin_amdgcn_exp2f(p0[r]);
}
__device__ __forceinline__ void finishSM(f32x16& p0, f32x16& p1, float alpha, float& l_reg, bf16x8& pa0, bf16x8& pa1, bf16x8& pa2, bf16x8& pa3) {
#pragma unroll
    for (int r = 0; r < 16; ++r) p1[r] = __builtin_amdgcn_exp2f(p1[r]);
    float ps = 0;
#pragma unroll
    for (int r = 0; r < 16; ++r) ps += p0[r];
#pragma unroll
    for (int r = 0; r < 16; ++r) ps += p1[r];
    { auto rr = __builtin_amdgcn_permlane32_swap(__float_as_uint(ps), __float_as_uint(ps), false, false);
      ps = __uint_as_float(rr[0]) + __uint_as_float(rr[1]); }
    l_reg = l_reg * alpha + ps;
#define PK4(P, BASE, OUT) do { unsigned a0 = pk2(P[BASE + 0], P[BASE + 1]), a1 = pk2(P[BASE + 2], P[BASE + 3]);   \
    unsigned b0 = pk2(P[BASE + 4], P[BASE + 5]), b1 = pk2(P[BASE + 6], P[BASE + 7]);                              \
    auto r0 = __builtin_amdgcn_permlane32_swap(a0, b0, false, false); auto r1 = __builtin_amdgcn_permlane32_swap(a1, b1, false, false); \
    u32x4 w = {r0[0], r1[0], r0[1], r1[1]}; OUT = *reinterpret_cast<bf16x8*>(&w); } while (0)
    PK4(p0, 0, pa0); PK4(p0, 8, pa1); PK4(p1, 0, pa2); PK4(p1, 8, pa3);
#undef PK4
}
template <int DQK>
__device__ __forceinline__ void qkt(f32x16& p0, f32x16& p1, const char* Ks, const bf16x8* qr, int kb0, int kb1, int kb2, int kb3) {
    p0 = f32x16{}; p1 = f32x16{};
#pragma unroll
    for (int d0 = 0; d0 < DQK / 16; ++d0) { const int kb = (d0 & 3) == 0 ? kb0 : (d0 & 3) == 1 ? kb1 : (d0 & 3) == 2 ? kb2 : kb3;
        const char* a = Ks + kb + (d0 >> 2) * 128;
        const bf16x8 b0 = *reinterpret_cast<const bf16x8*>(a);
        const bf16x8 b1 = *reinterpret_cast<const bf16x8*>(a + 32 * DQK * 2);
        p0 = __builtin_amdgcn_mfma_f32_32x32x16_bf16(b0, qr[d0], p0, 0, 0, 0);
        p1 = __builtin_amdgcn_mfma_f32_32x32x16_bf16(b1, qr[d0], p1, 0, 0, 0); }
}
__device__ __forceinline__ int v_st(int k, int c) { const int kk = (k & ~0xC) | ((k & 4) << 1) | ((k & 8) >> 1); return ((kk >> 3) * 4 + (c >> 5)) * 512 + ((kk & 7) * 32 + (c & 31)) * 2; }
__device__ __forceinline__ int v_rd_base(int lane) { return ((lane & 3) << 3) | (((lane >> 2) & 3) << 6) | (((lane >> 4) & 1) << 5) | (((lane >> 5) & 1) << 8); }
constexpr int v_rd_off(int d0, int ks, int half) { return d0 * 512 + ks * 4096 + half * 2048; }
template <int OFF> __device__ __forceinline__ s16x4 tr_read(int vb) {
    s16x4 r; asm volatile("ds_read_b64_tr_b16 %0, %1 offset:%2" : "=&v"(r) : "v"(vb), "i"(OFF) : "memory"); return r;
}
template <int D0> __device__ __forceinline__ void pv_one(f32x16& od, int vb, bf16x8 pa0, bf16x8 pa1, bf16x8 pa2, bf16x8 pa3) {
    const s16x4 l0 = tr_read<v_rd_off(D0, 0, 0)>(vb), h0 = tr_read<v_rd_off(D0, 0, 1)>(vb), l1 = tr_read<v_rd_off(D0, 1, 0)>(vb), h1 = tr_read<v_rd_off(D0, 1, 1)>(vb);
    const s16x4 l2 = tr_read<v_rd_off(D0, 2, 0)>(vb), h2 = tr_read<v_rd_off(D0, 2, 1)>(vb), l3 = tr_read<v_rd_off(D0, 3, 0)>(vb), h3 = tr_read<v_rd_off(D0, 3, 1)>(vb);
    asm volatile("s_waitcnt lgkmcnt(0)" ::: "memory"); SBAR();
#define PK(L, H) (bf16x8){L[0], L[1], L[2], L[3], H[0], H[1], H[2], H[3]}
    od = __builtin_amdgcn_mfma_f32_32x32x16_bf16(pa0, PK(l0, h0), od, 0, 0, 0);
    od = __builtin_amdgcn_mfma_f32_32x32x16_bf16(pa1, PK(l1, h1), od, 0, 0, 0);
    od = __builtin_amdgcn_mfma_f32_32x32x16_bf16(pa2, PK(l2, h2), od, 0, 0, 0);
    od = __builtin_amdgcn_mfma_f32_32x32x16_bf16(pa3, PK(l3, h3), od, 0, 0, 0);
#undef PK
}
__device__ __forceinline__ void pv_d0(f32x16* o, int vb, bf16x8 pa0, bf16x8 pa1, bf16x8 pa2, bf16x8 pa3) {
    pv_one<0>(o[0], vb, pa0, pa1, pa2, pa3); pv_one<1>(o[1], vb, pa0, pa1, pa2, pa3); pv_one<2>(o[2], vb, pa0, pa1, pa2, pa3); pv_one<3>(o[3], vb, pa0, pa1, pa2, pa3);
}
template <int DQK, bool DO_QK, bool DO_PV>
__device__ __forceinline__ void mstep(f32x16& p0, f32x16& p1, f32x16* o, const char* Ks, const bf16x8* qr, int kb0, int kb1, int kb2, int kb3,
                                      const char* Vs, bf16x8 pa0, bf16x8 pa1, bf16x8 pa2, bf16x8 pa3) {
    constexpr int ND = DQK / 16, W = 3;
    bf16x8 kf0[ND], kf1[ND]; s16x4 vl[16], vh[16];
    __builtin_amdgcn_s_setprio(1);
#define LDKF(d) do { const int kb_ = ((d) & 3) == 0 ? kb0 : ((d) & 3) == 1 ? kb1 : ((d) & 3) == 2 ? kb2 : kb3; const char* a_ = Ks + kb_ + ((d) >> 2) * 128; \
    kf0[d] = *reinterpret_cast<const bf16x8*>(a_); kf1[d] = *reinterpret_cast<const bf16x8*>(a_ + 32 * DQK * 2); } while (0)
#define LDVF(m) do { vl[m] = __builtin_amdgcn_ds_read_tr16_b64_v4i16((LAS s16x4*)(Vs + v_rd_off((m) >> 2, (m) & 3, 0))); vh[m] = __builtin_amdgcn_ds_read_tr16_b64_v4i16((LAS s16x4*)(Vs + v_rd_off((m) >> 2, (m) & 3, 1))); } while (0)
    if (DO_QK) { p0 = f32x16{}; p1 = f32x16{};
#pragma unroll
        for (int d = 0; d < W; ++d) LDKF(d);
#pragma unroll
        for (int d = 0; d < ND; ++d) {
            if (d + W < ND) LDKF(d + W); else if (DO_PV) LDVF(d + W - ND);
            SBAR();
            p0 = __builtin_amdgcn_mfma_f32_32x32x16_bf16(kf0[d], qr[d], p0, 0, 0, 0);
            p1 = __builtin_amdgcn_mfma_f32_32x32x16_bf16(kf1[d], qr[d], p1, 0, 0, 0);
            SBAR(); }
    } else {
#pragma unroll
        for (int m = 0; m < W; ++m) LDVF(m);
    }
    if (DO_PV) {
#pragma unroll
        for (int m = 0; m < 16; ++m) {
            if (m + W < 16) LDVF(m + W);
            SBAR();
            const bf16x8 vv = (bf16x8){vl[m][0], vl[m][1], vl[m][2], vl[m][3], vh[m][0], vh[m][1], vh[m][2], vh[m][3]};
            const bf16x8 pa = (m & 3) == 0 ? pa0 : (m & 3) == 1 ? pa1 : (m & 3) == 2 ? pa2 : pa3;
            o[m >> 2] = __builtin_amdgcn_mfma_f32_32x32x16_bf16(pa, vv, o[m >> 2], 0, 0, 0);
            SBAR(); }
    }
    __builtin_amdgcn_s_setprio(0);
#undef LDKF
#undef LDVF
}
struct NoMod { __device__ __forceinline__ void operator()(f32x16&, f32x16&, int, int, int, int) const {} };
struct NaMod {
    const float* btab;
    int r0, lo;
    __device__ __forceinline__ void operator()(f32x16& p0, f32x16& p1, int t, int wid, int r32, int hi) const {
        if (t < 4) return;
        const int kr = lo + t - 4, r = r0 + (wid >> 1); const int rs = min(max(r - 4, 0), 56); const bool vrow = kr >= rs && kr < rs + 8;
        const int c = (wid & 1) * 32 + r32, cs = min(max(c - 8, 0), 48); const int dr = vrow ? kr - r + 7 : 0;
        const float* bt = btab + dr * 31 + 15 - c;
#pragma unroll
        for (int g = 0; g < 16; ++g) { const int kc0 = crow(g, hi), kc1 = 32 + kc0;
            const bool ok0 = vrow && kc0 >= cs && kc0 < cs + 16, ok1 = vrow && kc1 >= cs && kc1 < cs + 16;
            const float b0 = bt[ok0 ? kc0 : c - 15], b1 = bt[ok1 ? kc1 : c - 15];
            p0[g] = ok0 ? p0[g] + b0 : -1e30f; p1[g] = ok1 ? p1[g] + b1 : -1e30f; }
    }
};

template <int DQK> struct Lds { static constexpr int SHM_V = KVBLK * DV * 2, SHM_K = KVBLK * DQK * 2, WS_OFF = 2 * SHM_V + 2 * SHM_K, BT_OFF = WS_OFF + 8 * 64 * 4, TOTAL = BT_OFF + 2048; };

template <int DQK, int LDQ, int LDK, int LDV, int LDO, int G, class Mod, int PRB = 0>
__device__ __forceinline__ void attn_body(const bf16_t* __restrict__ Qb, const bf16_t* __restrict__ Kn, const bf16_t* __restrict__ Kp, const bf16_t* __restrict__ Vh,
                                          bf16_t* __restrict__ Ob, int NT, int loff, const Mod& mod, char* lds) {
    constexpr int SHM_V = Lds<DQK>::SHM_V, SHM_K = Lds<DQK>::SHM_K; constexpr bool PE = DQK == 192;
    const int tid = threadIdx.x, wid = tid >> 6, lane = tid & 63, r32 = lane & 31, hi = lane >> 5;
    char* V_lds = lds; char* K_lds = lds + 2 * SHM_V;
    float* wsl = (float*)(lds + Lds<DQK>::WS_OFF) + wid * 64; float* li_l = wsl; float* al_l = wsl + 32;
    float m_reg = -1e30f, l_reg = 0; f32x16 o[4] = {}; bf16x8 qr[DQK / 16];
    const bf16_t* Qw = Qb + (long)(wid * QBLK + r32) * LDQ + hi * 8;
#pragma unroll
    for (int d0 = 0; d0 < DQK / 16; ++d0) qr[d0] = *reinterpret_cast<const bf16x8*>(Qw + d0 * 16);
    const int sr = tid >> 4, sc = (tid & 15) * 8, vst0 = v_st(sr, sc), vst1 = v_st(32 + sr, sc);
    const int pr = tid >> 3, pc = (tid & 7) * 8;
    const int vb0 = (int)(uintptr_t)V_lds + v_rd_base(lane);
    bf16x8 vs0 = {}, vs1 = {}, ks0 = {}, ks1 = {}, kp = {};
    const unsigned ko0 = (unsigned)(sr * LDK + sc), po0 = (unsigned)(pr * 64 + pc), vo0 = (unsigned)(sr * LDV + sc);
#define KROW(t) ((t) * KVBLK + ((t) >= 4 ? loff : 0))
#define KLOAD(t) do { if (PRB & 1) break; const bf16_t* kt_ = Kn + (size_t)KROW(t) * LDK; ks0 = *reinterpret_cast<const bf16x8*>(kt_ + ko0); ks1 = *reinterpret_cast<const bf16x8*>(kt_ + 32 * LDK + ko0); \
    if constexpr (PE) { const bf16_t* pt_ = Kp + (size_t)KROW(t) * 64; kp = *reinterpret_cast<const bf16x8*>(pt_ + po0); } } while (0)
#define VLOAD(t) do { if (PRB & 1) break; const bf16_t* vt_ = Vh + (size_t)KROW(t) * LDV; vs0 = *reinterpret_cast<const bf16x8*>(vt_ + vo0); vs1 = *reinterpret_cast<const bf16x8*>(vt_ + 32 * LDV + vo0); } while (0)
#define KWRITE(b) do { const int kc = sc * 2; *(bf16x8*)(K_lds + (b) * SHM_K + kswz<DQK>(sr, kc)) = ks0; *(bf16x8*)(K_lds + (b) * SHM_K + kswz<DQK>(32 + sr, kc)) = ks1; \
    if constexpr (PE) *(bf16x8*)(K_lds + (b) * SHM_K + kswz<DQK>(pr, 256 + pc * 2)) = kp; } while (0)
#define VWRITE(b) do { *(bf16x8*)(V_lds + (b) * SHM_V + vst0) = vs0; *(bf16x8*)(V_lds + (b) * SHM_V + vst1) = vs1; } while (0)
#define RESC(a) do { if (__any((a) < 1.f)) { if (hi == 0) al_l[r32] = (a); asm volatile("s_waitcnt lgkmcnt(0)" ::: "memory"); \
    _Pragma("unroll") for (int d = 0; d < 4; ++d) _Pragma("unroll") for (int r = 0; r < 16; ++r) o[d][r] *= al_l[crow(r, hi)]; } } while (0)
#define STAGE(s_) do { const int s__ = (s_), t__ = s__ >> 1; \
    if (!(s__ & 1)) { if (t__ + 1 < NT) KLOAD(t__ + 1); if (t__ < NT) VLOAD(t__); } \
    else { asm volatile("s_waitcnt vmcnt(0)" ::: "memory"); if (t__ + 1 < NT) KWRITE((t__ + 1) & 1); if (t__ < NT) VWRITE(t__ & 1); } } while (0)
#define SOFTMAX(t_) do { if (PRB & 2) break; mod(p0, p1, (t_), wid, r32, hi); partialSM<DQK>(p0, p1, m_reg, mn, al); RESC(al); finishSM(p0, p1, al, l_reg, pa0, pa1, pa2, pa3); } while (0)
    f32x16 p0 = {}, p1 = {}; float mn, al = 1.f; bf16x8 pa0 = {}, pa1 = {}, pa2 = {}, pa3 = {};
    int kb0 = kswz<DQK>(r32, 0 * 32 + hi * 16), kb1 = kswz<DQK>(r32, 1 * 32 + hi * 16), kb2 = kswz<DQK>(r32, 2 * 32 + hi * 16), kb3 = kswz<DQK>(r32, 3 * 32 + hi * 16);
    asm volatile("" : "+v"(kb0), "+v"(kb1), "+v"(kb2), "+v"(kb3));
#define PRE(s_) do { if (G == 1) STAGE(s_); } while (0)
#define POST(s_) do { if (G == 0) STAGE(s_); } while (0)
#define ABAR() do { asm volatile("s_waitcnt lgkmcnt(0)" ::: "memory"); __builtin_amdgcn_s_barrier(); asm volatile("" ::: "memory"); } while (0)
    KLOAD(0); asm volatile("s_waitcnt vmcnt(0)" ::: "memory"); KWRITE(0); ABAR();
    if (G == 1) { STAGE(0); ABAR(); }
    const char* Vrd = V_lds + v_rd_base(lane);
    PRE(G); SBAR(); if (!(PRB & 4)) mstep<DQK, true, false>(p0, p1, o, K_lds, qr, kb0, kb1, kb2, kb3, Vrd, pa0, pa1, pa2, pa3); POST(G); ABAR();
    for (int t = 0; t < NT - 1; ++t) {
        PRE(G + 2 * t + 1); SOFTMAX(t); POST(G + 2 * t + 1); ABAR();
        PRE(G + 2 * t + 2); SBAR(); if (!(PRB & 4)) mstep<DQK, true, true>(p0, p1, o, K_lds + ((t + 1) & 1) * SHM_K, qr, kb0, kb1, kb2, kb3, Vrd + (t & 1) * SHM_V, pa0, pa1, pa2, pa3); SBAR(); POST(G + 2 * t + 2); ABAR();
    }
    PRE(G + 2 * NT - 1); SOFTMAX(NT - 1); POST(G + 2 * NT - 1); ABAR();
    SBAR(); if (!(PRB & 4)) mstep<DQK, false, true>(p0, p1, o, K_lds, qr, kb0, kb1, kb2, kb3, Vrd + ((NT - 1) & 1) * SHM_V, pa0, pa1, pa2, pa3); ABAR();
    if (G == 0) { ABAR(); }
#undef ABAR
#undef PRE
#undef POST
#undef STAGE
#undef SOFTMAX
    if (hi == 0) li_l[r32] = l_reg; asm volatile("s_waitcnt lgkmcnt(0)" ::: "memory");
    int lane_e = lane; asm volatile("" : "+v"(lane_e));
    const int r32e = lane_e & 31, hie = lane_e >> 5;
    bf16_t* Ow = Ob + (long)(wid * QBLK + 4 * hie) * LDO + r32e;
#pragma unroll
    for (int r = 0; r < 16; ++r) { const int orow = (r & 3) + 8 * (r >> 2); const float rl = __builtin_amdgcn_rcpf(li_l[orow + 4 * hie]);
#pragma unroll
        for (int d0 = 0; d0 < 4; ++d0) { const unsigned w = pk2(o[d0][r] * rl, 0.f); Ow[(long)orow * LDO + d0 * 32] = (bf16_t)(w & 0xffffu); } }
#undef KROW
#undef KLOAD
#undef VLOAD
#undef KWRITE
#undef VWRITE
#undef RESC
}

struct NoMod2 { __device__ __forceinline__ void operator()(f32x16& p, int, int, int, int, int) const { p = f32x16{}; } };
struct NaMod2 {
    const float* btab; int r0, lo;
    __device__ __forceinline__ void operator()(f32x16& p, int t, int hf, int wid, int r32, int hi) const {
        if (t < 4) { p = f32x16{}; return; }
        const int kr = lo + t - 4, r = r0 + (wid >> 1); const int rs = min(max(r - 4, 0), 56);
        if (!(kr >= rs && kr < rs + 8)) {
#pragma unroll
            for (int g = 0; g < 16; ++g) p[g] = -1e30f;
            return; }
        const int c = (wid & 1) * 32 + r32, cs = min(max(c - 8, 0), 48);
        const int d = 4 * hi + 32 * hf - cs;
        const float* bt = btab + (kr - r + 7) * 31 + 15 - c + 4 * hi + 32 * hf;
#pragma unroll
        for (int g = 0; g < 16; ++g) { const int K0 = (g & 3) + 8 * (g >> 2); const bool ok = (unsigned)(K0 + d) < 16u; const float bv = bt[K0]; p[g] = ok ? bv : -1e30f; }
    }
};
__device__ __forceinline__ float max3f(float a, float b, float c) { return __builtin_fmaxf(__builtin_fmaxf(a, b), c); }
#define PK4V(P, BASE, OUT) do { unsigned a0 = pk2(P[BASE + 0], P[BASE + 1]), a1 = pk2(P[BASE + 2], P[BASE + 3]);   \
    unsigned b0 = pk2(P[BASE + 4], P[BASE + 5]), b1 = pk2(P[BASE + 6], P[BASE + 7]);                              \
    auto r0 = __builtin_amdgcn_permlane32_swap(a0, b0, false, false); auto r1 = __builtin_amdgcn_permlane32_swap(a1, b1, false, false); \
    u32x4 w = {r0[0], r1[0], r0[1], r1[1]}; OUT = *reinterpret_cast<bf16x8*>(&w); } while (0)

template <int DQK, int HFK, int HFV, bool DO_QK, bool DO_SM, bool DO_PV, class Mod>
__device__ __forceinline__ void region(f32x16& pn, f32x16& pc, bf16x8 pal, bf16x8 pah, bf16x8& pbl, bf16x8& pbh, f32x16* o, float& m_reg, float& l_reg, float& al,
                                       const LAS char* Kb, const bf16x8* qr, int kb0, int kb1, int kb2, int kb3, const LAS char* Vrd, const Mod& mod, int tmod, int hfmod, int wid, int r32, int hi, const char* Qpe, int qx) {
    constexpr int ND = DQK / 16, NQ = DO_QK ? ND : 0, NP = DO_PV ? 8 : 0, NM = NQ + NP, W = (DQK == 192 ? 2 : 3), NS = 10;
    constexpr float SCALE = Sc<DQK>::SCALE, C = SCALE * 1.4426950408889634f, THRS = THR / SCALE;
    bf16x8 kf[ND]; s16x4 vl[8], vh[8];
    float t0 = 0.f, t1 = 0.f, t2 = 0.f, t3 = 0.f, t4 = 0.f, pmax = 0.f, mnC = 0.f, ps = 0.f;
#define LDF(j) do { if ((j) < NQ) { const int kb_ = ((j) & 3) == 0 ? kb0 : ((j) & 3) == 1 ? kb1 : ((j) & 3) == 2 ? kb2 : kb3; \
        kf[(j) < NQ ? (j) : 0] = *reinterpret_cast<const LAS bf16x8*>(Kb + kb_ + ((j) >> 2) * 128 + HFK * 32 * DQK * 2); } \
    else { constexpr int m_ = (j) - NQ >= 0 ? ((j) - NQ) & 7 : 0; \
        vl[m_] = __builtin_amdgcn_ds_read_tr16_b64_v4i16((LAS s16x4*)(LAS char*)(Vrd + v_rd_off(m_ >> 1, 2 * HFV + (m_ & 1), 0))); \
        vh[m_] = __builtin_amdgcn_ds_read_tr16_b64_v4i16((LAS s16x4*)(LAS char*)(Vrd + v_rd_off(m_ >> 1, 2 * HFV + (m_ & 1), 1))); } } while (0)
#define MMF(j) do { if ((j) < NQ) { pn = __builtin_amdgcn_mfma_f32_32x32x16_bf16(kf[(j) < NQ ? (j) : 0], qr[(j) < NQ ? (j) : 0], pn, 0, 0, 0); } \
    else { constexpr int m_ = (j) - NQ >= 0 ? ((j) - NQ) & 7 : 0; const bf16x8 vv_ = (bf16x8){vl[m_][0], vl[m_][1], vl[m_][2], vl[m_][3], vh[m_][0], vh[m_][1], vh[m_][2], vh[m_][3]}; \
        o[m_ >> 1] = __builtin_amdgcn_mfma_f32_32x32x16_bf16((m_ & 1) ? pah : pal, vv_, o[m_ >> 1], 0, 0, 0); } } while (0)
    if (DO_QK) mod(pn, tmod, hfmod, wid, r32, hi);
    [&]<int... J>(std::integer_sequence<int, J...>) { ((J < NM && J < W ? (void)([&] { LDF(J); }()) : (void)0), ...); }(std::make_integer_sequence<int, 3>{});
    [&]<int... S>(std::integer_sequence<int, S...>) {
        (([&] {
            constexpr int jb = S * NM / NS, je = (S + 1) * NM / NS;
            [&]<int... Q>(std::integer_sequence<int, Q...>) {
                (([&] { constexpr int j = jb + Q; if constexpr (j < je) { if constexpr (j + W < NM) { LDF(j + W); } MMF(j); } }()), ...);
            }(std::make_integer_sequence<int, 3>{});
            if constexpr (DO_SM) {
                if constexpr (S == 0) { t0 = max3f(pc[0], pc[1], pc[2]); t1 = max3f(pc[3], pc[4], pc[5]); t2 = max3f(pc[6], pc[7], pc[8]); }
                if constexpr (S == 1) { t3 = max3f(pc[9], pc[10], pc[11]); t4 = max3f(pc[12], pc[13], pc[14]); t0 = max3f(t0, t1, pc[15]); t2 = max3f(t2, t3, t4); pmax = fmaxf(t0, t2);
                    auto rr = __builtin_amdgcn_permlane32_swap(__float_as_uint(pmax), __float_as_uint(pmax), false, false); pmax = fmaxf(__uint_as_float(rr[0]), __uint_as_float(rr[1])); }
                if constexpr (S == 2) { const bool keep = __all(pmax - m_reg <= THRS); const float mn = keep ? m_reg : fmaxf(m_reg, pmax); al = __builtin_amdgcn_exp2f((m_reg - mn) * C); m_reg = mn; mnC = -mn * C; }
                if constexpr (S >= 3 && S <= 6) {
#pragma unroll
                    for (int r = 4 * (S - 3); r < 4 * (S - 3) + 4; ++r) pc[r] = __builtin_amdgcn_exp2f(fmaf(pc[r], C, mnC)); }
                if constexpr (S == 7) { ps = ((pc[0] + pc[1]) + (pc[2] + pc[3])) + ((pc[4] + pc[5]) + (pc[6] + pc[7])) + (((pc[8] + pc[9]) + (pc[10] + pc[11])) + ((pc[12] + pc[13]) + (pc[14] + pc[15]))); }
                if constexpr (S == 8) { auto rr = __builtin_amdgcn_permlane32_swap(__float_as_uint(ps), __float_as_uint(ps), false, false); ps = __uint_as_float(rr[0]) + __uint_as_float(rr[1]);
                    l_reg = l_reg * al + ps; PK4V(pc, 0, pbl); }
                if constexpr (S == 9) { PK4V(pc, 8, pbh); }
            }
            SBAR();
        }()), ...);
    }(std::make_integer_sequence<int, NS>{});
#undef LDF
#undef MMF
}

template <int DQK, int LDQ, int LDK, int LDV, int LDO, class Mod>
__device__ __forceinline__ void attn_body2(const bf16_t* __restrict__ Qb, const bf16_t* __restrict__ Kn, const bf16_t* __restrict__ Kp, const bf16_t* __restrict__ Vh,
                                           bf16_t* __restrict__ Ob, int NT, int loff, const Mod& mod, char* lds, const int tid) {
    constexpr int SHM_V = Lds<DQK>::SHM_V, SHM_K = Lds<DQK>::SHM_K; constexpr bool PE = DQK == 192;
    const int wid = __builtin_amdgcn_readfirstlane(tid >> 6), lane = tid & 63, r32 = lane & 31, hi = lane >> 5;
    LAS char* V_lds = (LAS char*)lds; LAS char* K_lds = V_lds + 2 * SHM_V;
    float* wsl = (float*)(lds + Lds<DQK>::WS_OFF) + wid * 64; float* li_l = wsl; float* al_l = wsl + 32;
    float m_reg = -1e30f, l_reg = 0; f32x16 o[4] = {}; bf16x8 qr[DQK / 16];
    const bf16_t* Qw = Qb + (long)(wid * QBLK + r32) * LDQ + hi * 8;
#pragma unroll
    for (int d0 = 0; d0 < DQK / 16; ++d0) qr[d0] = *reinterpret_cast<const bf16x8*>(Qw + d0 * 16);
    const int qx = 0; const char* Qpe = lds;
    const int sr = tid >> 4, sc = (tid & 15) * 8, vst0 = v_st(sr, sc), vst1 = vst0 + 8192;
    const int pr = tid >> 3, pc_ = (tid & 7) * 8;
    bf16x8 vs0 = {}, vs1 = {}, ks0 = {}, ks1 = {}, kp = {};
    const int kw0 = kswz<DQK>(sr, sc * 2), kwp = kswz<DQK>(pr, 256 + pc_ * 2);
    const unsigned ko0 = (unsigned)(sr * LDK + sc), po0 = (unsigned)(pr * 64 + pc_), vo0 = (unsigned)(sr * LDV + sc);
#define KROW(t) ((t) * KVBLK + ((t) >= 4 ? loff : 0))
#define KLOAD(t) do { const bf16_t* kt_ = Kn + (size_t)KROW(t) * LDK; ks0 = *reinterpret_cast<const bf16x8*>(kt_ + ko0); ks1 = *reinterpret_cast<const bf16x8*>(kt_ + 32 * LDK + ko0); \
    if constexpr (PE) { const bf16_t* pt_ = Kp + (size_t)KROW(t) * 64; kp = *reinterpret_cast<const bf16x8*>(pt_ + po0); } } while (0)
#define VLOAD(t) do { const bf16_t* vt_ = Vh + (size_t)KROW(t) * LDV; vs0 = *reinterpret_cast<const bf16x8*>(vt_ + vo0); vs1 = *reinterpret_cast<const bf16x8*>(vt_ + 32 * LDV + vo0); } while (0)
#define KWRITE(b) do { *(LAS bf16x8*)(K_lds + (b) * SHM_K + kw0) = ks0; *(LAS bf16x8*)(K_lds + (b) * SHM_K + kw0 + 32 * DQK * 2) = ks1; \
    if constexpr (PE) *(LAS bf16x8*)(K_lds + (b) * SHM_K + kwp) = kp; } while (0)
#define VWRITE(b) do { *(LAS bf16x8*)(V_lds + (b) * SHM_V + vst0) = vs0; *(LAS bf16x8*)(V_lds + (b) * SHM_V + vst1) = vs1; } while (0)
#define RESC(a) do { if (__any((a) < 1.f)) { if (hi == 0) al_l[r32] = (a); asm volatile("s_waitcnt lgkmcnt(0)" ::: "memory"); \
    _Pragma("unroll") for (int d = 0; d < 4; ++d) _Pragma("unroll") for (int r = 0; r < 16; ++r) o[d][r] *= al_l[crow(r, hi)]; } } while (0)
#define ABAR() do { asm volatile("s_waitcnt lgkmcnt(0)" ::: "memory"); __builtin_amdgcn_s_barrier(); asm volatile("" ::: "memory"); } while (0)
    int kb0 = kswz<DQK>(r32, 0 * 32 + hi * 16), kb1 = kswz<DQK>(r32, 1 * 32 + hi * 16), kb2 = kswz<DQK>(r32, 2 * 32 + hi * 16), kb3 = kswz<DQK>(r32, 3 * 32 + hi * 16);
    asm volatile("" : "+v"(kb0), "+v"(kb1), "+v"(kb2), "+v"(kb3));
    const LAS char* Vrd = V_lds + v_rd_base(lane);
    f32x16 P0 = {}, P1 = {}; bf16x8 A0l = {}, A0h = {}, A1l = {}, A1h = {}; float al = 1.f;
#define RA(...) __VA_ARGS__, wid, r32, hi, Qpe, qx
    KLOAD(0); VLOAD(0); asm volatile("s_waitcnt vmcnt(0)" ::: "memory"); KWRITE(0); VWRITE(0); KLOAD(1); ABAR();
    region<DQK, 0, 0, true, false, false, Mod>(P0, P1, A1l, A1h, A0l, A0h, o, m_reg, l_reg, al, K_lds, qr, kb0, kb1, kb2, kb3, Vrd, RA(mod, 0, 0));
    asm volatile("s_waitcnt vmcnt(0)" ::: "memory"); KWRITE(1); VLOAD(1);
    region<DQK, 1, 1, true, true, false, Mod>(P1, P0, A1l, A1h, A0l, A0h, o, m_reg, l_reg, al, K_lds, qr, kb0, kb1, kb2, kb3, Vrd, RA(mod, 0, 1));
    RESC(al); ABAR();
    asm volatile("s_waitcnt vmcnt(0)" ::: "memory"); VWRITE(1); if (2 < NT) KLOAD(2);
    region<DQK, 0, 0, true, true, true, Mod>(P0, P1, A0l, A0h, A1l, A1h, o, m_reg, l_reg, al, K_lds + SHM_K, qr, kb0, kb1, kb2, kb3, Vrd, RA(mod, 1, 0));
    RESC(al);
    for (int t = 1; t < NT - 1; ++t) {
        VLOAD(t + 1);
        region<DQK, 1, 1, true, true, true, Mod>(P1, P0, A1l, A1h, A0l, A0h, o, m_reg, l_reg, al, K_lds + (t & 1) * SHM_K, qr, kb0, kb1, kb2, kb3, Vrd + ((t - 1) & 1) * SHM_V, RA(mod, t, 1));
        asm volatile("s_waitcnt vmcnt(2)" ::: "memory"); KWRITE((t + 1) & 1);
        RESC(al); ABAR();
        asm volatile("s_waitcnt vmcnt(0)" ::: "memory"); VWRITE((t + 1) & 1); if (t + 2 < NT) KLOAD(t + 2);
        region<DQK, 0, 0, true, true, true, Mod>(P0, P1, A0l, A0h, A1l, A1h, o, m_reg, l_reg, al, K_lds + ((t + 1) & 1) * SHM_K, qr, kb0, kb1, kb2, kb3, Vrd + (t & 1) * SHM_V, RA(mod, t + 1, 0));
        RESC(al);
    }
    { const int t = NT - 1;
      region<DQK, 1, 1, true, true, true, Mod>(P1, P0, A1l, A1h, A0l, A0h, o, m_reg, l_reg, al, K_lds + (t & 1) * SHM_K, qr, kb0, kb1, kb2, kb3, Vrd + ((t - 1) & 1) * SHM_V, RA(mod, t, 1));
      RESC(al); ABAR();
      region<DQK, 0, 0, false, true, true, Mod>(P0, P1, A0l, A0h, A1l, A1h, o, m_reg, l_reg, al, K_lds, qr, kb0, kb1, kb2, kb3, Vrd + (t & 1) * SHM_V, RA(mod, t, 1));
      RESC(al);
      region<DQK, 0, 1, false, false, true, Mod>(P0, P1, A1l, A1h, A0l, A0h, o, m_reg, l_reg, al, K_lds, qr, kb0, kb1, kb2, kb3, Vrd + (t & 1) * SHM_V, RA(mod, t, 1)); }
#undef RA
    if (hi == 0) li_l[r32] = l_reg; asm volatile("s_waitcnt lgkmcnt(0)" ::: "memory");
    int lane_e = lane; asm volatile("" : "+v"(lane_e));
    const int r32e = lane_e & 31, hie = lane_e >> 5;
    bf16_t* Ow = Ob + (long)(wid * QBLK + 4 * hie) * LDO + r32e;
#pragma unroll
    for (int r = 0; r < 16; ++r) { const int orow = (r & 3) + 8 * (r >> 2); const float rl = __builtin_amdgcn_rcpf(li_l[orow + 4 * hie]);
#pragma unroll
        for (int d0 = 0; d0 < 4; ++d0) { const unsigned w = pk2(o[d0][r] * rl, 0.f); Ow[(long)orow * LDO + d0 * 32] = (bf16_t)(w & 0xffffu); } }
#undef KROW
#undef KLOAD
#undef VLOAD
#undef KWRITE
#undef VWRITE
#undef RESC
#undef ABAR
}
}

#ifndef ATT_V2_MLA
#define ATT_V2_MLA 1
#endif
#ifndef ATT_V2_NA
#define ATT_V2_NA 1
#endif
#ifndef MLA_SDEPTH
#define MLA_SDEPTH 1
#endif
template <int PRB = 0>
__device__ __forceinline__ void phase_mla_attn(const Params& p, const Frame& F, unsigned char* lds) {
    const bf16_t* Q = (const bf16_t*)(p.ws + WS_Q); const bf16_t* KV = (const bf16_t*)(p.ws + WS_KV); const bf16_t* KPE = (const bf16_t*)(p.ws + WS_KPE);
    bf16_t* O = (bf16_t*)(p.ws + (PRB ? WS_END : WS_H));
    for (int u = F.vcu; u < 1024 + 64; u += F.G) {
        int b, h, qrow, NT;
        if (u < 1024) { const int bh = u >> 4, qt = u & 15; b = bh >> 4; h = bh & 15; qrow = b * TB + CTXL + qt * 256; NT = TB / 64; }
        else { const int cu = u - 1024; b = cu >> 4; h = cu & 15; qrow = b * TB; NT = CTXL / 64; }
        const size_t brow = (size_t)b * TB;
        __syncthreads();
#if ATT_V2_MLA
        att::attn_body2<192, NQ, 256, 256, DM, att::NoMod2>(Q + (size_t)qrow * NQ + h * 192, KV + ((size_t)h * TROWS + brow) * 256, KPE + brow * 64, KV + ((size_t)h * TROWS + brow) * 256 + 128, O + (size_t)qrow * DM + h * 128, NT, 0, att::NoMod2{}, (char*)lds, F.tid);
#else
        if (F.wave < 4) att::attn_body<192, NQ, NKV, NKV, DM, 0, att::NoMod, PRB>(Q + (size_t)qrow * NQ + h * 192, KV + brow * NKV + h * 256, KPE + brow * 64, KV + brow * NKV + h * 256 + 128, O + (size_t)qrow * DM + h * 128, NT, 0, att::NoMod{}, (char*)lds);
        else att::attn_body<192, NQ, NKV, NKV, DM, 1, att::NoMod, PRB>(Q + (size_t)qrow * NQ + h * 192, KV + brow * NKV + h * 256, KPE + brow * 64, KV + brow * NKV + h * 256 + 128, O + (size_t)qrow * DM + h * 128, NT, 0, att::NoMod{}, (char*)lds);
#endif
    }
}
__device__ __forceinline__ void phase_na_attn(const Params& p, const Frame& F, unsigned char* lds) {
    const bf16_t* QKV = (const bf16_t*)(p.ws + WS_Q); bf16_t* O = (bf16_t*)(p.ws + WS_H);
    float* btab = (float*)(lds + att::Lds<128>::BT_OFF);
    for (int u = F.vcu; u < 1024; u += F.G) {
        const int bh = u >> 4, g = u & 15, b = bh >> 4, h = bh & 15, r0 = 4 * g;
        int lo = min(max(r0 - 4, 0), 56), hi_ = min(max(r0 - 1, 0), 56) + 8;
        const int NT = 4 + (hi_ - lo);
        const size_t brow = (size_t)b * TB; const int qrow = b * TB + CTXL + r0 * 64;
        __syncthreads();
        if (F.tid < 15 * 31) btab[F.tid] = p.na_bias[h * (15 * 31) + F.tid] * (1.0f / att::Sc<128>::SCALE);
#if ATT_V2_NA
        att::NaMod2 mod2{btab, r0, lo};
        att::attn_body2<128, 128, 128, 128, DM, att::NaMod2>(QKV + ((size_t)h * TROWS + qrow) * 128, QKV + ((size_t)(16 + h) * TROWS + brow) * 128, nullptr, QKV + ((size_t)(32 + h) * TROWS + brow) * 128, O + (size_t)qrow * DM + h * 128, NT, lo * 64, mod2, (char*)lds, F.tid);
#else
        att::NaMod mod{btab, r0, lo};
        if (F.wave < 4) att::attn_body<128, NQKV, NQKV, NQKV, DM, 0, att::NaMod>(QKV + (size_t)qrow * NQKV + h * 128, QKV + brow * NQKV + DM + h * 128, nullptr, QKV + brow * NQKV + 2 * DM + h * 128, O + (size_t)qrow * DM + h * 128, NT, lo * 64, mod, (char*)lds);
        else att::attn_body<128, NQKV, NQKV, NQKV, DM, 1, att::NaMod>(QKV + (size_t)qrow * NQKV + h * 128, QKV + brow * NQKV + DM + h * 128, nullptr, QKV + brow * NQKV + 2 * DM + h * 128, O + (size_t)qrow * DM + h * 128, NT, lo * 64, mod, (char*)lds);
#endif
    }
}

#define XB_TMO      128
#define XB_XCNT(j)  (256  + 64 * (j))
#define XB_XSUB(j)  (1280 + 64 * (j))
#define XB_XGEN(j)  (2304 + 64 * (j))
#define XB_TOP      3328
#define XB_TOPGEN   3392
#define XCD_BAR_WORDS 3456
#define XB_SPIN_CAP (1u << 18)

__device__ __forceinline__ unsigned xb_ld(unsigned* p)              { return __hip_atomic_load(p, __ATOMIC_RELAXED, __HIP_MEMORY_SCOPE_AGENT); }
__device__ __forceinline__ unsigned xb_add(unsigned* p, unsigned v) { return __hip_atomic_fetch_add(p, v, __ATOMIC_RELAXED, __HIP_MEMORY_SCOPE_AGENT); }
__device__ __forceinline__ unsigned xb_xcc_id() { return (unsigned)__builtin_amdgcn_s_getreg((3 << 11) | 20) & 0xFu; }
#define XB_SPIN(cond, bar) do { unsigned _sp = 0; while (cond) { __builtin_amdgcn_s_sleep(1); \
    if ((++_sp & 255u) == 0u) { if (xb_ld(&(bar)[XB_TMO])) break; if (_sp > XB_SPIN_CAP) { atomicAdd(&(bar)[XB_TMO], 1u); break; } } } } while (0)

struct XcdBarrier {
    unsigned* bar; unsigned x;
    volatile LAS unsigned* st;
};

__device__ __forceinline__ XcdBarrier xcd_barrier_post(unsigned* bar, volatile LAS unsigned* st) {
    XcdBarrier b; b.bar = bar; b.x = xb_xcc_id(); b.st = st;
    if (threadIdx.x == 0) (void)xb_add(&bar[XB_XCNT(b.x)], 1u);
    return b;
}
__device__ __forceinline__ void xcd_barrier_complete(unsigned* bar, unsigned x, unsigned& nloc, unsigned& nx) {
    const unsigned G = gridDim.x * gridDim.y * gridDim.z;
    unsigned sum, cnt, mine, sp = 0u;
    for (;;) {
        sum = 0u; cnt = 0u; mine = 0u;
#pragma unroll
        for (unsigned j = 0; j < 16; ++j) { const unsigned c = xb_ld(&bar[XB_XCNT(j)]); sum += c; cnt += (c > 0u) ? 1u : 0u; mine = (j == x) ? c : mine; }
        if (sum == G) break;
        __builtin_amdgcn_s_sleep(1);
        if ((++sp & 255u) == 0u) { if (xb_ld(&bar[XB_TMO])) break; if (sp > XB_SPIN_CAP) { atomicAdd(&bar[XB_TMO], 1u); break; } }
    }
    nloc = mine > 0u ? mine : 1u; nx = cnt > 0u ? cnt : 1u;
}

__device__ __forceinline__ void xcd_barrier(const XcdBarrier& b, const bool leader_thread) {
    asm volatile("s_waitcnt vmcnt(0)" ::: "memory");
    __syncthreads();
    if (leader_thread) {
        unsigned* bar = b.bar;
        __builtin_amdgcn_s_waitcnt(0);
        unsigned nloc = b.st[0], nx = b.st[1];
        if (nloc == 0u) { xcd_barrier_complete(bar, b.x, nloc, nx); b.st[0] = nloc; b.st[1] = nx; }
        const unsigned old = xb_add(&bar[XB_XSUB(b.x)], 1u);
        const unsigned gen = old / nloc;
        if (old + 1u == (gen + 1u) * nloc) {
            __builtin_amdgcn_fence(__ATOMIC_RELEASE, "agent");
            asm volatile("s_waitcnt vmcnt(0)" ::: "memory");
            const unsigned og = xb_add(&bar[XB_TOP], 1u);
            const unsigned tg = og / nx;
            if (og + 1u == (tg + 1u) * nx) xb_add(&bar[XB_TOPGEN], 1u);
            else XB_SPIN(xb_ld(&bar[XB_TOPGEN]) == tg, bar);
            __builtin_amdgcn_fence(__ATOMIC_ACQUIRE, "agent");
            xb_add(&bar[XB_XGEN(b.x)], 1u);
            asm volatile("s_waitcnt vmcnt(0)" ::: "memory");
        } else {
            XB_SPIN(xb_ld(&bar[XB_XGEN(b.x)]) == gen, bar);
            __builtin_amdgcn_fence(__ATOMIC_ACQUIRE, "agent");
            asm volatile("s_waitcnt vmcnt(0)" ::: "memory");
        }
    }
    __syncthreads();
}


constexpr int NPHASES = 18;
__device__ __forceinline__ Params load_params() {
    const __attribute__((address_space(4))) Params* q = (const __attribute__((address_space(4))) Params*)__builtin_amdgcn_kernarg_segment_ptr();
    asm volatile("" : "+s"(q)); Params r; __builtin_memcpy(&r, (const void*)q, sizeof(Params)); return r;
}
#define PL load_params()
__global__ void __launch_bounds__(NTHREADS) mega_fwd(Params p) {
    __builtin_assume(__builtin_amdgcn_workitem_id_y() == 0); __builtin_assume(__builtin_amdgcn_workitem_id_z() == 0);
    extern __shared__ __attribute__((aligned(16))) unsigned char lds_raw[];
    LAS unsigned char* lds = (LAS unsigned char*)lds_raw;
    const int wave_s = __builtin_amdgcn_readfirstlane((int)threadIdx.x >> 6);
#define MKFRAME() Frame F; { int ln_; asm volatile("v_mbcnt_lo_u32_b32 %0, -1, 0\n\tv_mbcnt_hi_u32_b32 %0, -1, %0" : "=v"(ln_)); F.lane = ln_; F.wave = wave_s; F.tid = wave_s * 64 + ln_; \
    F.G = gridDim.x; const int bx = blockIdx.x; F.vcu = (F.G % 8 == 0) ? (bx % 8) * (F.G / 8) + bx / 8 : bx; }
    cg::grid_group grid = cg::this_grid();
    unsigned char* ws = p.ws; asm volatile("" : "+s"(ws));
    const int lo = p.ph_lo, hi = p.ph_hi;
    float* XC = (float*)(ws + WS_XC); const float* MOD = (const float*)(ws + WS_MOD);
#ifndef PHASE_MASK
#define PHASE_MASK 0x3ffff
#endif
#define IN(k) (((PHASE_MASK >> (k)) & 1) && lo <= (k) && (k) < hi)
    volatile LAS unsigned* bst = (volatile LAS unsigned*)(lds + LDS_BYTES - 16);
    if (threadIdx.x < 4) bst[threadIdx.x] = 0u;
    __syncthreads();
    if (blockIdx.x == 0) { for (int i = threadIdx.x; i < 16384 / 16; i += NTHREADS) ((u32x4*)(ws + WS_CTL))[i] = (u32x4){0u, 0u, 0u, 0u}; __threadfence(); }
    if (hi - lo > 1) grid.sync();
    const XcdBarrier xbar = xcd_barrier_post((unsigned*)(ws + WS_CTL), bst);
#define GRID_BAR() do { const bool ldr_ = (wave_s == 0) && (__builtin_amdgcn_mbcnt_hi(~0u, __builtin_amdgcn_mbcnt_lo(~0u, 0u)) == 0u); xcd_barrier(xbar, ldr_); } while (0)
#define SEAM(k) do { if (IN(k) && IN((k) + 1)) GRID_BAR(); } while (0)

#ifndef DBL_MASK
#define DBL_MASK 0
#endif
#define DBL(k) ((DBL_MASK >> (k)) & 1)
#ifndef PRB_VAR
#define PRB_VAR 0
#endif
    if (IN(0)) { MKFRAME(); phase0(PL, F, lds); if (DBL(0)) { GRID_BAR(); phase0(PL, F, lds); } } SEAM(0);
    if (IN(1)) { MKFRAME(); phase_norm<true>(PL, F, 0, 0, false); } SEAM(1);
    if (IN(2)) { MKFRAME();
        pg8::Gemm g{(const bf16_t*)(ws + WS_H), (const bf16_t*)(ws + WS_WA), TROWS, NA_, DM, DM}; pg8::StaticOrder S; S.init(TROWS, NA_, F.G, (int)blockIdx.x);
        pg8::EpiBf16<0> E{(bf16_t*)(ws + WS_QA), NA_, nullptr, 0, 0};
        pg8::gemm_phase<pg8::EpiBf16<0>, pg8::StaticOrder, false>(lds, g, S, E, nullptr, F.tid);
    } SEAM(2);
    if (IN(3)) { MKFRAME(); phase_mla_norm(PL, F); } SEAM(3);
    if (IN(4)) { MKFRAME();
        { pg8::Gemm g{(const bf16_t*)(ws + WS_CQ), (const bf16_t*)(ws + WS_WUQ), TROWS, NQ, 512, 512}; pg8::StaticOrder S; S.init(TROWS, NQ, F.G, (int)blockIdx.x);
          EpiQ E{(bf16_t*)(ws + WS_Q), (const f32x2*)(ws + WS_ROPE)};
          pg8::gemm_phase<EpiQ, pg8::StaticOrder, false>(lds, g, S, E, nullptr, F.tid); }
        { pg8::Gemm g{(const bf16_t*)(ws + WS_CKV), (const bf16_t*)(ws + WS_WUKV), TROWS, NKV, 512, 512}; pg8::StaticOrder S; S.init(TROWS, NKV, F.G, (int)blockIdx.x);
          pg8::EpiBf16<0> E{(bf16_t*)(ws + WS_KV), 256, nullptr, 256, (size_t)TROWS * 256};
          pg8::gemm_phase<pg8::EpiBf16<0>, pg8::StaticOrder, false>(lds, g, S, E, nullptr, F.tid); }
    } SEAM(4);
    if (IN(5)) { MKFRAME(); phase_mla_attn(PL, F, lds_raw); if (DBL(5)) { GRID_BAR(); phase_mla_attn<PRB_VAR>(PL, F, lds_raw); } } SEAM(5);
    if (IN(6)) { MKFRAME();
        { pg8::Gemm g{(const bf16_t*)(ws + WS_H), (const bf16_t*)(ws + WS_WO0), TROWS, DM, DM, DM}; LatentOrder S; S.init(NBATCH * SEQ, DM, F.G, (int)blockIdx.x);
          EpiRes E{PL.x, PL.ctx, PL.out, XC, MOD + 2 * DM};
          pg8::gemm_phase<EpiRes, LatentOrder, false>(lds, g, S, E, nullptr, F.tid); }
        { pg8::Gemm g{(const bf16_t*)(ws + WS_H), (const bf16_t*)(ws + WS_WO0), TROWS, DM, DM / NSPLIT, DM}; CtxSplitOrder S; S.init(DM, DM, F.G, (int)blockIdx.x);
          EpiSlab E{(float*)(ws + WS_Q), S.kbytes};
          pg8::gemm_phase<EpiSlab, CtxSplitOrder, false>(lds, g, S, E, nullptr, F.tid); }
    } SEAM(6);
    if (IN(7)) { MKFRAME(); phase_norm<false, true>(PL, F, 0, 1, false, PL.ctx, MOD + 4 * 6 * DM + 2 * DM); } SEAM(7);
    if (IN(8)) { MKFRAME();
        pg8::Gemm g{(const bf16_t*)(ws + WS_H), (const bf16_t*)(ws + WS_WGU0), TROWS, NGU, DM, DM}; pg8::StaticOrder S; S.init(TROWS, NGU, F.G, (int)blockIdx.x);
        EpiSwiglu E{(bf16_t*)(ws + WS_ACT)};
        pg8::gemm_phase<EpiSwiglu, pg8::StaticOrder, false>(lds, g, S, E, nullptr, F.tid);
    } SEAM(8);
    if (IN(9)) { MKFRAME();
        { pg8::Gemm g{(const bf16_t*)(ws + WS_ACT), (const bf16_t*)(ws + WS_WD0), TROWS, DM, DFF, DFF}; LatentOrder S; S.init(NBATCH * SEQ, DM, F.G, (int)blockIdx.x);
          EpiRes E{PL.out, XC, PL.out, XC, MOD + 5 * DM};
          pg8::gemm_phase<EpiRes, LatentOrder, false>(lds, g, S, E, nullptr, F.tid); }
        { pg8::Gemm g{(const bf16_t*)(ws + WS_ACT), (const bf16_t*)(ws + WS_WD0), TROWS, DM, DFF / NSPLIT, DFF}; CtxSplitOrder S; S.init(DM, DFF, F.G, (int)blockIdx.x);
          EpiSlab E{(float*)(ws + WS_Q), S.kbytes};
          pg8::gemm_phase<EpiSlab, CtxSplitOrder, false>(lds, g, S, E, nullptr, F.tid); }
    } SEAM(9);
    if (IN(10)) { MKFRAME(); phase_norm<false, true>(PL, F, 1, 0, false, XC, MOD + 4 * 6 * DM + 5 * DM); } SEAM(10);
    if (IN(11)) { MKFRAME();
        pg8::Gemm g{(const bf16_t*)(ws + WS_H), (const bf16_t*)(ws + WS_WQKV), TROWS, NQKV, DM, DM}; pg8::StaticOrder S; S.init(TROWS, NQKV, F.G, (int)blockIdx.x);
        EpiHeads128 E{(bf16_t*)(ws + WS_Q)};
        pg8::gemm_phase<EpiHeads128, pg8::StaticOrder, false>(lds, g, S, E, nullptr, F.tid);
    } SEAM(11);
    if (IN(12)) { MKFRAME(); phase_na_attn(PL, F, lds_raw); if (DBL(12)) { GRID_BAR(); phase_na_attn(PL, F, lds_raw); } } SEAM(12);
    if (IN(13)) { MKFRAME();
        pg8::Gemm g{(const bf16_t*)(ws + WS_H), (const bf16_t*)(ws + WS_WO1), TROWS, DM, DM, DM}; LatentOrder S; S.init(NBATCH * SEQ, DM, F.G, (int)blockIdx.x);
        EpiRes E{PL.out, XC, PL.out, XC, MOD + 5 * 6 * DM + 2 * DM};
        pg8::gemm_phase<EpiRes, LatentOrder, false>(lds, g, S, E, nullptr, F.tid);
    } SEAM(13);
    if (IN(14)) { MKFRAME(); phase_norm<false>(PL, F, 1, 1, true); } SEAM(14);
    if (IN(15)) { MKFRAME();
        pg8::Gemm g{(const bf16_t*)(ws + WS_H), (const bf16_t*)(ws + WS_WGU1), TROWS, NGU, DM, DM}; LatentOrder S; S.init(NBATCH * SEQ, NGU, F.G, (int)blockIdx.x);
        EpiSwiglu E{(bf16_t*)(ws + WS_ACT)};
        pg8::gemm_phase<EpiSwiglu, LatentOrder, false>(lds, g, S, E, nullptr, F.tid);
    } SEAM(15);
    if (IN(16)) { MKFRAME();
        pg8::Gemm g{(const bf16_t*)(ws + WS_ACT), (const bf16_t*)(ws + WS_WD1), TROWS, DM, DFF, DFF}; LatentOrder S; S.init(NBATCH * SEQ, DM, F.G, (int)blockIdx.x);
        EpiRes E{PL.out, XC, PL.out, XC, MOD + 5 * 6 * DM + 5 * DM};
        pg8::gemm_phase<EpiRes, LatentOrder, false>(lds, g, S, E, nullptr, F.tid);
    } SEAM(16);
    if (IN(17)) { MKFRAME(); phase_final(PL, F); }
#undef IN
#undef SEAM
}

extern "C" void kernel_launch(void* const* d_in, const int* in_sizes, int n_in, void* d_out, int out_size, void* d_ws, size_t ws_size, hipStream_t stream) {
    static int grid = 0;
    if (grid == 0) {
        if (n_in != 22 || in_sizes[0] != NBATCH * SEQ * DM || out_size != NBATCH * SEQ * DM || ws_size < WS_END + (DBL_MASK ? (size_t)TROWS * DM * 2 : 0)) {
            fprintf(stderr, "kernel_launch: shape/workspace mismatch: n_in %d in0 %d out %d ws %zu (need %zu)\n", n_in, n_in > 0 ? in_sizes[0] : -1, out_size, ws_size, (size_t)WS_END); grid = -1; return; }
        int dev = 0, cus = 0, per_cu = 0;
        hipGetDevice(&dev); hipDeviceGetAttribute(&cus, hipDeviceAttributeMultiprocessorCount, dev);
        if (hipFuncSetAttribute((const void*)mega_fwd, hipFuncAttributeMaxDynamicSharedMemorySize, LDS_BYTES) != hipSuccess) { fprintf(stderr, "kernel_launch: hipFuncSetAttribute failed\n"); grid = -1; return; }
        if (hipOccupancyMaxActiveBlocksPerMultiprocessor(&per_cu, (const void*)mega_fwd, NTHREADS, LDS_BYTES) != hipSuccess || per_cu < 1) { fprintf(stderr, "kernel_launch: occupancy query says %d\n", per_cu); per_cu = 1; }
        (void)hipGetLastError();
        grid = cus * 1;
        fprintf(stderr, "kernel_launch: grid %d (cus %d, per_cu %d)\n", grid, cus, per_cu);
    }
    if (grid < 0) return;
    Params p{};
    const float* const* in = (const float* const*)d_in;
    p.x = in[0]; p.c = in[1]; p.ctx = in[2]; p.c_ctx = in[3]; p.ada_w = in[4]; p.ada_b = in[5]; p.norm_mix = in[6]; p.norm_ffn = in[7]; p.norm_final = in[8];
    p.w_dq = in[9]; p.q_norm = in[10]; p.w_uq = in[11]; p.w_dkv = in[12]; p.kv_norm = in[13]; p.w_ukv = in[14]; p.mla_wo = in[15];
    p.na_wqkv = in[16]; p.na_bias = in[17]; p.na_wo = in[18]; p.w_gate = in[19]; p.w_up = in[20]; p.w_down = in[21];
    p.out = (float*)d_out; p.ws = (unsigned char*)d_ws;
#if MK_ONE_LAUNCH
    p.ph_lo = 0; p.ph_hi = NPHASES;
    void* args[] = {&p};
    hipError_t e = hipLaunchCooperativeKernel((const void*)mega_fwd, dim3(grid), dim3(NTHREADS), args, LDS_BYTES, stream);
    if (e != hipSuccess) fprintf(stderr, "cooperative launch failed: %s (grid %d)\n", hipGetErrorString(e), grid);
#else
    for (int k = 0; k < NPHASES; ++k) { p.ph_lo = k; p.ph_hi = k + 1; hipLaunchKernelGGL(mega_fwd, dim3(grid), dim3(NTHREADS), LDS_BYTES, stream, p); }
#endif
}
```

```cpp
#define MK_ONE_LAUNCH 1
#include <hip/hip_runtime.h>
namespace pg8 {
#define PG8_LAS __attribute__((address_space(3)))
typedef unsigned short bf16_t;
typedef short bf16x8 __attribute__((ext_vector_type(8)));
typedef float f32x4 __attribute__((ext_vector_type(4)));
typedef unsigned u32x4 __attribute__((ext_vector_type(4)));
constexpr int BM = 256, BK = 64, HALF = 128, HTB = HALF * BK * 2  , STAGE_BYTES = 8 * HTB, NXCD = 8, WGM = 4;

__host__ __device__ __forceinline__ int lds_byte(int r, int c) { const int st = (r >> 4) * 2 + (c >> 5), rr = r & 15, cc = c & 31, ob = rr * 64 + cc * 2; return st * 1024 + (ob ^ (((ob >> 9) & 1) << 5)); }
__host__ __device__ __forceinline__ void stage_rc(int b, int& R, int& C) { const int st = b / 1024, sb = b % 1024, swz = sb ^ (((sb >> 9) & 1) << 5); R = (st >> 1) * 16 + swz / 64; C = (st & 1) * 32 + (swz % 64) / 2; }
__host__ __device__ __forceinline__ int perm32(int rho) { const int n = rho >> 4, i = rho & 15; return 8 * (i >> 2) + 4 * n + (i & 3); }

struct Unit { int pm, pn; int ko = 0; };
struct Gemm { const bf16_t* A; const bf16_t* Bt; int M, N, K; int ld; };

struct StaticOrder {
    int nM, nN, nwg, G, c;
    __host__ __device__ void init(int M, int N, int G_, int c_) { nM = M / BM; nN = N / BM; nwg = nM * nN; G = G_; c = c_; }
    __host__ __device__ bool next(int i, Unit& u) const {
        const long L = (long)i * G + c; if (L >= nwg) return false;
        int wgid = (int)L; { const int q = nwg / NXCD, r = nwg % NXCD, xcd = wgid % NXCD, off = wgid / NXCD; wgid = (xcd < r ? xcd * (q + 1) : r * (q + 1) + (xcd - r) * q) + off; }
        const int nig = WGM * nN, gid = wgid / nig, fm = gid * WGM, gsz = (nM - fm) < WGM ? (nM - fm) : WGM;
        u.pm = fm + ((wgid % nig) % gsz); u.pn = (wgid % nig) / gsz; return true;
    }
    __device__ __forceinline__ void a_ready(const Unit&) const {}
    __device__ __forceinline__ void done(const Unit&) const {}
};
struct CountedOrder : StaticOrder {
    const unsigned* ready; unsigned need; unsigned* tmo;
    __device__ __forceinline__ void a_ready(const Unit& u) const {
        if (threadIdx.x < 64) {
            const unsigned long long t0 = __builtin_amdgcn_s_memrealtime(); unsigned polls = 0;
            while ((unsigned)__builtin_amdgcn_readfirstlane(__hip_atomic_load(ready + 64 * u.pm, __ATOMIC_RELAXED, __HIP_MEMORY_SCOPE_AGENT)) < need) {
                if ((++polls & 255u) == 0u && __builtin_amdgcn_readfirstlane(__hip_atomic_load(tmo, __ATOMIC_RELAXED, __HIP_MEMORY_SCOPE_AGENT)) != 0u) break;
                if (__builtin_amdgcn_s_memrealtime() - t0 > 2000000ull) {
                    if (threadIdx.x == 0) { unsigned expect = 0u; __hip_atomic_compare_exchange_strong(tmo + 1, &expect, 0x600u | (unsigned)(u.pm & 0xff), __ATOMIC_RELAXED, __ATOMIC_RELAXED, __HIP_MEMORY_SCOPE_AGENT); __hip_atomic_store(tmo, 1u, __ATOMIC_RELAXED, __HIP_MEMORY_SCOPE_AGENT); }
                    break; }
                __builtin_amdgcn_s_sleep(2); }
            __builtin_amdgcn_fence(__ATOMIC_ACQUIRE, "agent");
            asm volatile("s_waitcnt vmcnt(0)" ::: "memory");
        }
#if !defined(BROKEN_HOOK_NO_BARRIER)
        asm volatile("" ::: "memory"); __builtin_amdgcn_s_barrier(); asm volatile("" ::: "memory");
#endif
    }
};

__device__ __forceinline__ unsigned cvt_pk_bf16(float lo, float hi) { unsigned r; asm volatile("v_cvt_pk_bf16_f32 %0, %1, %2" : "=v"(r) : "v"(lo), "v"(hi)); return r; }
typedef float f32x2 __attribute__((ext_vector_type(2)));
__device__ __forceinline__ f32x2 gelu_pk(f32x2 v) {
    const f32x2 av = __builtin_elementwise_abs(v), d = av * 0.2316418882f + 1.0f;
    f32x2 t; t.x = __builtin_amdgcn_rcpf(d.x); t.y = __builtin_amdgcn_rcpf(d.y);
    f32x2 q = t * 0.5307027145f + (-0.7265760135f); q = q * t + 0.7107068705f; q = q * t + (-0.142248368f); q = q * t + 0.127414796f; q = q * t;
    const f32x2 s = (v * v) * (-0.72134752044f);
    f32x2 e; e.x = __builtin_amdgcn_exp2f(s.x); e.y = __builtin_amdgcn_exp2f(s.y);
    const f32x2 m = v * (q * e), r = v - m;
    f32x2 o; o.x = v.x < 0.f ? m.x : r.x; o.y = v.y < 0.f ? m.y : r.y; return o;
}

struct EpiF32 {
    static constexpr bool PERM = false, AFTER_DRAIN = false;
    float* C; int ldc; const float* bias;
    __device__ __forceinline__ void operator()(const f32x4 (&acc)[2][2][4][2], const Unit& u, int wr, int wc, int fr, int fq) const {
        const int row0 = u.pm * BM + wr * 64 + fr, col0 = u.pn * BM + wc * 32 + 4 * fq;
        f32x4 bv[2][2];
#pragma unroll
        for (int bj = 0; bj < 2; ++bj)
#pragma unroll
            for (int n = 0; n < 2; ++n) bv[bj][n] = bias ? *(const f32x4*)(bias + col0 + bj * HALF + n * 16) : (f32x4){0.f, 0.f, 0.f, 0.f};
#pragma unroll
        for (int ai = 0; ai < 2; ++ai)
#pragma unroll
            for (int m = 0; m < 4; ++m) { float* rowp = C + (size_t)(row0 + ai * HALF + m * 16) * ldc + col0;
#pragma unroll
                for (int bj = 0; bj < 2; ++bj)
#pragma unroll
                    for (int n = 0; n < 2; ++n) *(f32x4*)(rowp + bj * HALF + n * 16) = acc[ai][bj][m][n] + bv[bj][n]; }
    }
};
template <int ACT  > struct EpiBf16 {
    static constexpr bool PERM = true, AFTER_DRAIN = false;
    bf16_t* O; int ldc; const float* bias; int split_cols; size_t split_stride;
    __device__ __forceinline__ void operator()(const f32x4 (&acc)[2][2][4][2], const Unit& u, int wr, int wc, int fr, int fq) const {
        const int row0 = u.pm * BM + wr * 64 + fr; int colt = u.pn * BM; bf16_t* base = O;
        if (split_cols) { const int t = colt / split_cols; base += (size_t)t * split_stride; colt -= t * split_cols; }
        const int col0 = colt + wc * 32 + 8 * fq, bcol0 = u.pn * BM + wc * 32 + 8 * fq;
        f32x4 bv[2][2];
#pragma unroll
        for (int bj = 0; bj < 2; ++bj)
#pragma unroll
            for (int n = 0; n < 2; ++n) bv[bj][n] = bias ? *(const f32x4*)(bias + bcol0 + bj * HALF + 4 * n) : (f32x4){0.f, 0.f, 0.f, 0.f};
#pragma unroll
        for (int ai = 0; ai < 2; ++ai)
#pragma unroll
            for (int m = 0; m < 4; ++m) { bf16_t* rowp = base + (size_t)(row0 + ai * HALF + m * 16) * ldc + col0;
#pragma unroll
                for (int bj = 0; bj < 2; ++bj) { f32x4 v0 = acc[ai][bj][m][0] + bv[bj][0], v1 = acc[ai][bj][m][1] + bv[bj][1];
                    if (ACT == 1) { f32x2 a = gelu_pk((f32x2){v0[0], v0[1]}), b = gelu_pk((f32x2){v0[2], v0[3]}), c = gelu_pk((f32x2){v1[0], v1[1]}), d = gelu_pk((f32x2){v1[2], v1[3]});
                        v0 = (f32x4){a.x, a.y, b.x, b.y}; v1 = (f32x4){c.x, c.y, d.x, d.y}; }
                    if (ACT == 2) {
#pragma unroll
                        for (int j = 0; j < 4; ++j) { v0[j] = 0.5f * v0[j] * (1.0f + erff(v0[j] * 0.70710678f)); v1[j] = 0.5f * v1[j] * (1.0f + erff(v1[j] * 0.70710678f)); } }
                    u32x4 w; w.x = cvt_pk_bf16(v0[0], v0[1]); w.y = cvt_pk_bf16(v0[2], v0[3]); w.z = cvt_pk_bf16(v1[0], v1[1]); w.w = cvt_pk_bf16(v1[2], v1[3]);
                    *(u32x4*)(rowp + bj * HALF) = w; } }
    }
};

template <class Epi, class Sched, bool STAMP = false, bool ALIGN_EPI = true, bool SP2 = true>
__device__ __forceinline__ void gemm_phase(PG8_LAS unsigned char* lds, const Gemm g, const Sched& S, const Epi& E, unsigned long long* stamps, const int tid_in) {
    const int tid = tid_in, wid = __builtin_amdgcn_readfirstlane(tid >> 6), lane = tid & 63, wr = wid >> 2, wc = wid & 3, fr = lane & 15, fq = lane >> 4;
    const int K = g.ld, nt = g.K / BK;
    int ts_lo = 0, ts_hi = 0, nts = 0; const unsigned long long rt_entry = STAMP ? (unsigned long long)wall_clock64() : 0ull;
#define PG8_STAMP() do { if (STAMP && wid == 0 && nts < 64) { const unsigned long long _c = (unsigned long long)clock64(); \
        ts_lo = (lane == nts) ? (int)(unsigned)_c : ts_lo; ts_hi = (lane == nts) ? (int)(unsigned)(_c >> 32) : ts_hi; ++nts; } } while (0)
    PG8_STAMP();
    unsigned voffA[2], voffB[2];
#pragma unroll
    for (int i = 0; i < 2; ++i) { int R, C; stage_rc(tid * 16 + i * 8192, R, C); const int Rb = Epi::PERM ? ((R & ~31) + perm32(R & 31)) : R;
        voffA[i] = (unsigned)(R * K + C) * 2u; voffB[i] = (unsigned)(Rb * K + C) * 2u; }
    const size_t kstep = (size_t)(BK * 2);
    const size_t hstep = (size_t)HALF * K * 2;
    const size_t tstep = 2 * hstep;
    const unsigned ldsw = (unsigned)wid * 1024u;
    const int aoff = lds_byte(wr * 64 + fr, fq * 8), boff = lds_byte(wc * 32 + fr, fq * 8);
#define PG8_SA(b, h) (((b) * 2 + (h)) * HTB)
#define PG8_SB(b, h) ((4 + (b) * 2 + (h)) * HTB)
#define PG8_STAGE(bufoff, gbase, voff) do { _Pragma("unroll") for (int _i = 0; _i < 2; ++_i) \
        __builtin_amdgcn_global_load_lds((const unsigned*)((const char*)(gbase) + (voff)[_i]), (PG8_LAS unsigned*)(lds + (bufoff) + ldsw + _i * 8192), 16, 0, 0); } while (0)
#define PG8_LDA(dst, b, h) do { _Pragma("unroll") for (int m = 0; m < 4; ++m) _Pragma("unroll") for (int k = 0; k < 2; ++k) dst[m][k] = *(const PG8_LAS bf16x8*)(lds + PG8_SA(b, h) + aoff + m * 2048 + k * 1024); } while (0)
#define PG8_LDB(dst, b, h) do { _Pragma("unroll") for (int n = 0; n < 2; ++n) _Pragma("unroll") for (int k = 0; k < 2; ++k) dst[n][k] = *(const PG8_LAS bf16x8*)(lds + PG8_SB(b, h) + boff + n * 2048 + k * 1024); } while (0)
#define PG8_MMA(ai, bj, At, Bt) do { __builtin_amdgcn_s_setprio(1); _Pragma("unroll") for (int m = 0; m < 4; ++m) _Pragma("unroll") for (int n = 0; n < 2; ++n) _Pragma("unroll") for (int k = 0; k < 2; ++k) \
        acc[ai][bj][m][n] = __builtin_amdgcn_mfma_f32_16x16x32_bf16(Bt[n][k], At[m][k], acc[ai][bj][m][n], 0, 0, 0); __builtin_amdgcn_s_setprio(0); } while (0)
#define PG8_WAIT_V(n) asm volatile("s_waitcnt vmcnt(" #n ")" ::: "memory")
#define PG8_WAIT_L(n) asm volatile("s_waitcnt lgkmcnt(" #n ")" ::: "memory")
#define PG8_BAR __builtin_amdgcn_s_barrier()
#define PG8_SCHED __builtin_amdgcn_sched_barrier(0)
    Unit cur, nxt; int ui = 0;
    if (!S.next(0, cur)) return;
    f32x4 acc[2][2][4][2];
#pragma unroll
    for (int a = 0; a < 2; ++a)
#pragma unroll
        for (int b = 0; b < 2; ++b)
#pragma unroll
            for (int m = 0; m < 4; ++m)
#pragma unroll
                for (int n = 0; n < 2; ++n) acc[a][b][m][n] = (f32x4){0.f, 0.f, 0.f, 0.f};
    bf16x8 At[4][2], B0[2][2], B1[2][2];
    const char* cA = (const char*)g.A + (size_t)cur.pm * tstep + (size_t)cur.ko; const char* cB = (const char*)g.Bt + (size_t)cur.pn * tstep + (size_t)cur.ko;
    S.a_ready(cur);
    if constexpr (SP2) {
        PG8_STAGE(PG8_SB(0, 0), cB, voffB); PG8_STAGE(PG8_SB(0, 1), cB + hstep, voffB); PG8_STAGE(PG8_SA(0, 0), cA, voffA); PG8_STAGE(PG8_SA(0, 1), cA + hstep, voffA);
        if (wr == 1) PG8_BAR;
        PG8_WAIT_V(2); PG8_BAR;
        PG8_STAGE(PG8_SB(1, 0), cB + kstep, voffB); PG8_STAGE(PG8_SA(1, 0), cA + kstep, voffA); PG8_STAGE(PG8_SB(1, 1), cB + hstep + kstep, voffB);
        PG8_WAIT_V(6); PG8_BAR;
    } else {
        PG8_STAGE(PG8_SB(0, 0), cB, voffB); PG8_STAGE(PG8_SA(0, 0), cA, voffA); PG8_STAGE(PG8_SB(0, 1), cB + hstep, voffB); PG8_STAGE(PG8_SA(0, 1), cA + hstep, voffA);
        if (wr == 1) PG8_BAR;
        PG8_WAIT_V(4); PG8_BAR;
        PG8_STAGE(PG8_SB(1, 0), cB + kstep, voffB); PG8_STAGE(PG8_SA(1, 0), cA + kstep, voffA); PG8_STAGE(PG8_SB(1, 1), cB + hstep + kstep, voffB);
        PG8_WAIT_V(6); PG8_BAR;
    }
    PG8_STAMP();
    for (;;) {
        const bool has_next = S.next(ui + 1, nxt);
        const char* nA = has_next ? (const char*)g.A + (size_t)nxt.pm * tstep + (size_t)nxt.ko : cA; const char* nB = has_next ? (const char*)g.Bt + (size_t)nxt.pn * tstep + (size_t)nxt.ko : cB;
        for (int t = 0; t < nt; t += 2) {
            const bool last = (t == nt - 2);
            const char* a1 = cA + (size_t)(t + 1) * kstep;
            const char* a2 = last ? nA : cA + (size_t)(t + 2) * kstep; const char* b2 = last ? nB : cB + (size_t)(t + 2) * kstep;
            const char* a3 = a2 + kstep; const char* b3 = b2 + kstep;
            if (last && has_next) S.a_ready(nxt);
            if constexpr (SP2) {
            PG8_LDB(B0, 0, 0); PG8_LDB(B1, 0, 1); PG8_SCHED; PG8_LDA(At, 0, 0); PG8_STAGE(PG8_SA(1, 1), a1 + hstep, voffA);
            PG8_WAIT_V(8); PG8_WAIT_L(0); PG8_BAR; PG8_MMA(0, 0, At, B0); PG8_MMA(0, 1, At, B1); PG8_BAR; PG8_SCHED;
            PG8_LDA(At, 0, 1); PG8_STAGE(PG8_SB(0, 0), b2, voffB); PG8_STAGE(PG8_SB(0, 1), b2 + hstep, voffB); PG8_STAGE(PG8_SA(0, 0), a2, voffA);
            PG8_WAIT_V(8); PG8_WAIT_L(0); PG8_BAR; PG8_MMA(1, 0, At, B0); PG8_MMA(1, 1, At, B1); PG8_BAR; PG8_SCHED;
            PG8_LDB(B0, 1, 0); PG8_LDB(B1, 1, 1); PG8_SCHED; PG8_LDA(At, 1, 0); PG8_STAGE(PG8_SA(0, 1), a2 + hstep, voffA);
            PG8_WAIT_V(8); PG8_WAIT_L(0); PG8_BAR; PG8_MMA(0, 0, At, B0); PG8_MMA(0, 1, At, B1); PG8_BAR; PG8_SCHED;
            PG8_LDA(At, 1, 1); PG8_STAGE(PG8_SB(1, 0), b3, voffB); PG8_STAGE(PG8_SB(1, 1), b3 + hstep, voffB); PG8_STAGE(PG8_SA(1, 0), a3, voffA);
            PG8_WAIT_V(8); PG8_WAIT_L(0); PG8_BAR; PG8_MMA(1, 0, At, B0); PG8_MMA(1, 1, At, B1); PG8_BAR; PG8_SCHED;
            } else {
            PG8_LDB(B0, 0, 0); PG8_SCHED; PG8_LDA(At, 0, 0); PG8_STAGE(PG8_SA(1, 1), a1 + hstep, voffA);
            PG8_WAIT_L(8); PG8_BAR; PG8_WAIT_L(0); PG8_MMA(0, 0, At, B0); PG8_BAR; PG8_SCHED;
            PG8_LDB(B1, 0, 1); PG8_STAGE(PG8_SB(0, 0), b2, voffB);
            PG8_BAR; PG8_WAIT_L(0); PG8_MMA(0, 1, At, B1); PG8_BAR;
            PG8_LDA(At, 0, 1); PG8_STAGE(PG8_SA(0, 0), a2, voffA);
            PG8_BAR; PG8_WAIT_L(0); PG8_MMA(1, 0, At, B0); PG8_BAR; PG8_SCHED;
            PG8_STAGE(PG8_SB(0, 1), b2 + hstep, voffB);
            PG8_WAIT_V(6); PG8_BAR; PG8_MMA(1, 1, At, B1); PG8_BAR;
            PG8_LDB(B0, 1, 0); PG8_SCHED; PG8_LDA(At, 1, 0); PG8_STAGE(PG8_SA(0, 1), a2 + hstep, voffA);
            PG8_WAIT_L(8); PG8_BAR; PG8_WAIT_L(0); PG8_MMA(0, 0, At, B0); PG8_BAR; PG8_SCHED;
            PG8_LDB(B1, 1, 1); PG8_STAGE(PG8_SB(1, 0), b3, voffB);
            PG8_BAR; PG8_WAIT_L(0); PG8_MMA(0, 1, At, B1); PG8_BAR;
            PG8_LDA(At, 1, 1); PG8_STAGE(PG8_SA(1, 0), a3, voffA);
            PG8_BAR; PG8_WAIT_L(0); PG8_MMA(1, 0, At, B0); PG8_BAR; PG8_SCHED;
            PG8_STAGE(PG8_SB(1, 1), b3 + hstep, voffB);
            PG8_WAIT_V(6); PG8_BAR; PG8_MMA(1, 1, At, B1); PG8_BAR;
            }
        }
        PG8_STAMP();
        if constexpr (ALIGN_EPI) { if (wr == 0) PG8_BAR; }
        if constexpr (!Epi::AFTER_DRAIN) { E(acc, cur, wr, wc, fr, fq); S.done(cur); }
        PG8_STAMP();
        if (!has_next) break;
#pragma unroll
        for (int a = 0; a < 2; ++a)
#pragma unroll
            for (int b = 0; b < 2; ++b)
#pragma unroll
                for (int m = 0; m < 4; ++m)
#pragma unroll
                    for (int n = 0; n < 2; ++n) acc[a][b][m][n] = (f32x4){0.f, 0.f, 0.f, 0.f};
        cur = nxt; cA = nA; cB = nB; ++ui;
        if constexpr (ALIGN_EPI) { if (wr == 1) PG8_BAR; }
    }
    PG8_WAIT_V(0);
    if constexpr (!ALIGN_EPI) { if (wr == 0) PG8_BAR; }
    PG8_BAR;
    if constexpr (Epi::AFTER_DRAIN) { E.fused(acc, cur, wr, wc, fr, fq, lds, wid, lane); S.done(cur); }
    PG8_STAMP();
    if (STAMP && wid == 0) { stamps[lane] = lane < nts ? (((unsigned long long)(unsigned)ts_hi << 32) | (unsigned)ts_lo) : 0ull;
        if (lane == 62) stamps[62] = rt_entry; if (lane == 63) stamps[63] = (unsigned long long)wall_clock64(); }
#undef PG8_STAMP
#undef PG8_SA
#undef PG8_SB
#undef PG8_STAGE
#undef PG8_LDA
#undef PG8_LDB
#undef PG8_MMA
#undef PG8_WAIT_V
#undef PG8_WAIT_L
#undef PG8_BAR
#undef PG8_SCHED
}
}


#include <hip/hip_cooperative_groups.h>
#include <cstdio>
#include <utility>
namespace cg = cooperative_groups;

#ifndef MK_ONE_LAUNCH
#define MK_ONE_LAUNCH 1
#endif

#define LAS __attribute__((address_space(3)))
typedef unsigned short bf16_t;
typedef short bf16x8 __attribute__((ext_vector_type(8)));
typedef short s16x4 __attribute__((ext_vector_type(4)));
typedef float f32x4 __attribute__((ext_vector_type(4)));
typedef float f32x2 __attribute__((ext_vector_type(2)));
typedef float f32x8 __attribute__((ext_vector_type(8)));
typedef float f32x16 __attribute__((ext_vector_type(16)));
typedef unsigned u32x4 __attribute__((ext_vector_type(4)));
typedef unsigned u32x2 __attribute__((ext_vector_type(2)));

constexpr int DM = 2048, NBATCH = 4, SEQ = 4096, CTXL = 256, TB = SEQ + CTXL  , TROWS = NBATCH * TB  ;
constexpr int NH = 16, DFF = 5632, NA_ = 1280  , NQ = 3072, NKV = 4096, NQKV = 6144, NGU = 2 * DFF;
constexpr int NWAVES = 8, NTHREADS = 512;
constexpr float EPS = 1e-6f;

constexpr size_t al256(size_t x) { return (x + 255) / 256 * 256; }
constexpr size_t WS_WA = 0;
constexpr size_t WS_WUQ = WS_WA + al256((size_t)NA_ * DM * 2);
constexpr size_t WS_WUKV = WS_WUQ + al256((size_t)NQ * 512 * 2);
constexpr size_t WS_WO0 = WS_WUKV + al256((size_t)NKV * 512 * 2);
constexpr size_t WS_WQKV = WS_WO0 + al256((size_t)DM * DM * 2);
constexpr size_t WS_WO1 = WS_WQKV + al256((size_t)NQKV * DM * 2);
constexpr size_t WS_WGU0 = WS_WO1 + al256((size_t)DM * DM * 2);
constexpr size_t WS_WGU1 = WS_WGU0 + al256((size_t)NGU * DM * 2);
constexpr size_t WS_WD0 = WS_WGU1 + al256((size_t)NGU * DM * 2);
constexpr size_t WS_WD1 = WS_WD0 + al256((size_t)DM * DFF * 2);
constexpr size_t WS_MOD = WS_WD1 + al256((size_t)DM * DFF * 2);
constexpr size_t WS_ROPE = WS_MOD + al256((size_t)2 * 5 * 6 * DM * 4);
constexpr size_t WS_CTL = WS_ROPE + al256(64 * 16 * 8);
constexpr size_t WS_XC = WS_CTL + 16384;
constexpr size_t WS_H = WS_XC + al256((size_t)NBATCH * CTXL * DM * 4);
constexpr size_t WS_Q = WS_H + al256((size_t)TROWS * DM * 2);
constexpr size_t WS_KV = WS_Q + al256((size_t)TROWS * NQ * 2);
constexpr size_t WS_ACT = WS_KV + al256((size_t)TROWS * NKV * 2);
constexpr size_t WS_QA = WS_ACT;
constexpr size_t WS_CQ = WS_QA + al256((size_t)TROWS * NA_ * 4);
constexpr size_t WS_CKV = WS_CQ + al256((size_t)TROWS * 512 * 2);
constexpr size_t WS_KPE = WS_CKV + al256((size_t)TROWS * 512 * 2);
constexpr size_t WS_END = WS_ACT + al256((size_t)TROWS * DFF * 2);
static_assert(WS_KPE + (size_t)TROWS * 64 * 2 <= WS_END, "alias region");
static_assert((size_t)TROWS * NQKV * 2 <= WS_ACT - WS_Q, "qkv alias");

constexpr int LDS_BYTES = 131072 + 4096;

struct Params {
    const float *x, *c, *ctx, *c_ctx, *ada_w, *ada_b, *norm_mix, *norm_ffn, *norm_final;
    const float *w_dq, *q_norm, *w_uq, *w_dkv, *kv_norm, *w_ukv, *mla_wo, *na_wqkv, *na_bias, *na_wo, *w_gate, *w_up, *w_down;
    float* out; unsigned char* ws;
    int ph_lo, ph_hi;
};

struct Frame { int tid, lane, wave, G, vcu; };

__device__ __forceinline__ unsigned pk2(float lo, float hi) { unsigned r; asm volatile("v_cvt_pk_bf16_f32 %0, %1, %2" : "=v"(r) : "v"(lo), "v"(hi)); return r; }
__device__ __forceinline__ float wave_sum(float v) {
#pragma unroll
    for (int o = 1; o < 64; o <<= 1) v += __shfl_xor(v, o);
    return v;
}
__device__ __forceinline__ float silu_f(float v) { return v / (1.0f + __expf(-v)); }
__device__ __forceinline__ int rope_perm(int d) { return d < 16 ? 2 * d : d < 32 ? 2 * (d - 16) + 1 : d < 48 ? 2 * (d - 16) : 2 * (d - 32) + 1; }

template <int KIND> __device__ __forceinline__ int dst_row(int n) {
    if (KIND == 0) return n;
    if (KIND == 1) return n < 512 ? 512 + n : 1024 + rope_perm(n - 512);
    if (KIND == 2) { const int h = n / 192, d = n - h * 192; return h * 192 + (d < 128 ? d : 128 + rope_perm(d - 128)); }
    if (KIND == 3) return (n >> 7) * 256 + (n & 127);
    return (n >> 7) * 256 + 128 + (n & 127);
}
template <int KIND>
__device__ __forceinline__ void transpose_item(const float* __restrict__ W, int K, int N, bf16_t* __restrict__ WT, LAS float* scr, int item, int lane) {
    const int nblk = N / 32, kb = item / nblk, nb = item - kb * nblk, k0 = 64 * kb, n0 = 32 * nb;
    float tv[32];
#pragma unroll
    for (int i = 0; i < 32; ++i) { const int kk = 2 * i + (lane >> 5); tv[i] = W[(size_t)(k0 + kk) * N + n0 + (lane & 31)]; }
#pragma unroll
    for (int i = 0; i < 32; ++i) { const int kk = 2 * i + (lane >> 5); scr[kk * 33 + (lane & 31)] = tv[i]; }
    asm volatile("s_waitcnt lgkmcnt(0)" ::: "memory");
    const int c = lane & 7;
#pragma unroll
    for (int j = 0; j < 4; ++j) { const int n = (lane >> 3) + 8 * j; const LAS float* s = scr + (8 * c) * 33 + n;
        u32x4 o; o.x = pk2(s[0 * 33], s[1 * 33]); o.y = pk2(s[2 * 33], s[3 * 33]); o.z = pk2(s[4 * 33], s[5 * 33]); o.w = pk2(s[6 * 33], s[7 * 33]);
        *(u32x4*)(WT + (size_t)dst_row<KIND>(n0 + n) * K + k0 + 8 * c) = o; }
    asm volatile("s_waitcnt lgkmcnt(0)" ::: "memory");
}

__device__ __forceinline__ void phase0(const Params& p, const Frame& F, LAS unsigned char* lds) {
    unsigned char* ws = p.ws;
    { const int gt = blockIdx.x * NTHREADS + F.tid;
      if (gt < 64 * 16) { const int pos = gt >> 4, f = gt & 15; const float inv = powf(10000.0f, -(float)f / 16.0f); const float ang = (float)pos * inv;
          const double a = (double)ang; const double n = rint(a * 0.15915494309189535); const float r = (float)(a - n * 6.283185307179586);
          ((f32x2*)(ws + WS_ROPE))[gt] = (f32x2){__cosf(r), __sinf(r)}; } }
    { bf16_t* wa = (bf16_t*)(ws + WS_WA) + (size_t)1088 * DM; const int n16 = 192 * DM / 8;
      for (int i = blockIdx.x * NTHREADS + F.tid; i < n16; i += F.G * NTHREADS) ((u32x4*)wa)[i] = (u32x4){0u, 0u, 0u, 0u}; }
    if ((int)blockIdx.x < 192) {
        LAS float* sc = (LAS float*)lds;
        LAS float* red = (LAS float*)(lds + 5 * 2048 * 4);
        for (int i = F.tid; i < 5 * 2048; i += NTHREADS) { const int r = i >> 11, k = i & 2047; const float v = r < 4 ? p.c[r * DM + k] : p.c_ctx[k]; sc[i] = silu_f(v); }
        __syncthreads();
        const int item = blockIdx.x, l = item / 96, nb = item % 96, n = nb * 128 + F.lane * 2;
        const float* W = p.ada_w + (size_t)l * DM * (6 * DM) + n;
        float a0[5] = {0.f, 0.f, 0.f, 0.f, 0.f}, a1[5] = {0.f, 0.f, 0.f, 0.f, 0.f};
        const int kbeg = F.wave * 256;
        for (int k = kbeg; k < kbeg + 256; k += 8) {
            f32x2 w[8];
#pragma unroll
            for (int u = 0; u < 8; ++u) w[u] = *(const f32x2*)(W + (size_t)(k + u) * (6 * DM));
#pragma unroll
            for (int r = 0; r < 5; ++r) {
                const f32x4 s0 = *(const LAS f32x4*)(sc + r * 2048 + k), s1 = *(const LAS f32x4*)(sc + r * 2048 + k + 4);
                a0[r] += s0.x * w[0].x + s0.y * w[1].x + s0.z * w[2].x + s0.w * w[3].x + s1.x * w[4].x + s1.y * w[5].x + s1.z * w[6].x + s1.w * w[7].x;
                a1[r] += s0.x * w[0].y + s0.y * w[1].y + s0.z * w[2].y + s0.w * w[3].y + s1.x * w[4].y + s1.y * w[5].y + s1.z * w[6].y + s1.w * w[7].y;
            }
        }
#pragma unroll
        for (int r = 0; r < 5; ++r) { red[(F.wave * 5 + r) * 128 + F.lane * 2] = a0[r]; red[(F.wave * 5 + r) * 128 + F.lane * 2 + 1] = a1[r]; }
        __syncthreads();
        for (int i = F.tid; i < 5 * 128; i += NTHREADS) { const int r = i >> 7, cc = i & 127; float s = 0.f;
#pragma unroll
            for (int w = 0; w < 8; ++w) s += red[(w * 5 + r) * 128 + cc];
            const int nn = nb * 128 + cc; ((float*)(ws + WS_MOD))[(size_t)(l * 5 + r) * (6 * DM) + nn] = s + p.ada_b[l * 6 * DM + nn]; }
        __syncthreads();
    }
    LAS float* scr = (LAS float*)(lds + F.wave * 16384);
    const int gw = F.vcu * NWAVES + F.wave, NGW = F.G * NWAVES;
    constexpr int I0 = 32 * 16, I1 = 32 * 18, I2 = 8 * 96, I3 = 8 * 128, I4 = 32 * 64, I5 = 32 * 192, I6 = 32 * 64, IG = 32 * 176, ID = 88 * 64;
    constexpr int NITEMS = I0 + I1 + I2 + I3 + I4 + I5 + I6 + 4 * IG + 2 * ID;
    for (int it = gw; it < NITEMS; it += NGW) {
        int r = it;
        if (r < I0) { transpose_item<0>(p.w_dq, DM, 512, (bf16_t*)(ws + WS_WA), scr, r, F.lane); continue; } r -= I0;
        if (r < I1) { transpose_item<1>(p.w_dkv, DM, 576, (bf16_t*)(ws + WS_WA), scr, r, F.lane); continue; } r -= I1;
        if (r < I2) { transpose_item<2>(p.w_uq, 512, NQ, (bf16_t*)(ws + WS_WUQ), scr, r, F.lane); continue; } r -= I2;
        if (r < I3) { transpose_item<0>(p.w_ukv, 512, NKV, (bf16_t*)(ws + WS_WUKV), scr, r, F.lane); continue; } r -= I3;
        if (r < I4) { transpose_item<0>(p.mla_wo, DM, DM, (bf16_t*)(ws + WS_WO0), scr, r, F.lane); continue; } r -= I4;
        if (r < I5) { transpose_item<0>(p.na_wqkv, DM, NQKV, (bf16_t*)(ws + WS_WQKV), scr, r, F.lane); continue; } r -= I5;
        if (r < I6) { transpose_item<0>(p.na_wo, DM, DM, (bf16_t*)(ws + WS_WO1), scr, r, F.lane); continue; } r -= I6;
        if (r < IG) { transpose_item<3>(p.w_gate, DM, DFF, (bf16_t*)(ws + WS_WGU0), scr, r, F.lane); continue; } r -= IG;
        if (r < IG) { transpose_item<4>(p.w_up, DM, DFF, (bf16_t*)(ws + WS_WGU0), scr, r, F.lane); continue; } r -= IG;
        if (r < IG) { transpose_item<3>(p.w_gate + (size_t)DM * DFF, DM, DFF, (bf16_t*)(ws + WS_WGU1), scr, r, F.lane); continue; } r -= IG;
        if (r < IG) { transpose_item<4>(p.w_up + (size_t)DM * DFF, DM, DFF, (bf16_t*)(ws + WS_WGU1), scr, r, F.lane); continue; } r -= IG;
        if (r < ID) { transpose_item<0>(p.w_down, DFF, DM, (bf16_t*)(ws + WS_WD0), scr, r, F.lane); continue; } r -= ID;
        transpose_item<0>(p.w_down + (size_t)DFF * DM, DFF, DM, (bf16_t*)(ws + WS_WD1), scr, r, F.lane);
    }
}

constexpr int NSPLIT = 4;
template <bool FROM_INPUT, bool PEND = false>
__device__ __forceinline__ void phase_norm(const Params& p, const Frame& F, int layer, int which, bool skip_ctx, const float* ctx_src = nullptr, const float* pend_gate = nullptr) {
    const int gw = F.vcu * NWAVES + F.wave, NGW = F.G * NWAVES;
    const float* gn = (which ? p.norm_ffn : p.norm_mix) + layer * DM;
    const float* mod = (const float*)(p.ws + WS_MOD) + (size_t)layer * 5 * 6 * DM;
    bf16_t* Hb = (bf16_t*)(p.ws + WS_H);
    for (int row = gw; row < TROWS; row += NGW) {
        const int b = row / TB, rb = row - b * TB; const bool isctx = rb < CTXL;
        if (isctx && skip_ctx) continue;
        const float* src;
        if (FROM_INPUT) src = isctx ? p.ctx + (size_t)(b * CTXL + rb) * DM : p.x + (size_t)(b * SEQ + rb - CTXL) * DM;
        else src = isctx ? (const float*)(p.ws + WS_XC) + (size_t)(b * CTXL + rb) * DM : p.out + (size_t)(b * SEQ + rb - CTXL) * DM;
        const float* mr = mod + (size_t)(isctx ? 4 : b) * 6 * DM + (which ? 3 : 0) * DM;
        f32x4 v[8]; float ss = 0.f;
        if (PEND && isctx) {
            const size_t ro = (size_t)(b * CTXL + rb) * DM; const float* sl = (const float*)(p.ws + WS_Q) + ro; float* xc = (float*)(p.ws + WS_XC) + ro;
#pragma unroll
            for (int j = 0; j < 8; ++j) { const int c = 4 * F.lane + 256 * j; f32x4 a = *(const f32x4*)(sl + c);
#pragma unroll
                for (int q = 1; q < NSPLIT; ++q) a += *(const f32x4*)(sl + (size_t)q * NBATCH * CTXL * DM + c);
                v[j] = *(const f32x4*)(ctx_src + ro + c) + *(const f32x4*)(pend_gate + c) * a; *(f32x4*)(xc + c) = v[j];
                ss += (v[j].x * v[j].x + v[j].y * v[j].y) + (v[j].z * v[j].z + v[j].w * v[j].w); }
        } else {
#pragma unroll
        for (int j = 0; j < 8; ++j) { v[j] = *(const f32x4*)(src + 4 * F.lane + 256 * j); ss += (v[j].x * v[j].x + v[j].y * v[j].y) + (v[j].z * v[j].z + v[j].w * v[j].w); }
        }
        const float rstd = rsqrtf(wave_sum(ss) * (1.0f / DM) + EPS);
#pragma unroll
        for (int j = 0; j < 8; ++j) { const int c = 4 * F.lane + 256 * j;
            const f32x4 g = *(const f32x4*)(gn + c), sh = *(const f32x4*)(mr + c), sc = *(const f32x4*)(mr + DM + c);
            const f32x4 y = (v[j] * rstd * g) * (sc + 1.0f) + sh;
            u32x2 o; o.x = pk2(y.x, y.y); o.y = pk2(y.z, y.w);
            *(u32x2*)(Hb + (size_t)row * DM + c) = o; }
    }
}

__device__ __forceinline__ void phase_mla_norm(const Params& p, const Frame& F) {
    const int gw = F.vcu * NWAVES + F.wave, NGW = F.G * NWAVES;
    const bf16_t* QA = (const bf16_t*)(p.ws + WS_QA);
    bf16_t* CQ = (bf16_t*)(p.ws + WS_CQ); bf16_t* CKV = (bf16_t*)(p.ws + WS_CKV); bf16_t* KPE = (bf16_t*)(p.ws + WS_KPE);
    const f32x2* rope = (const f32x2*)(p.ws + WS_ROPE);
    for (int row = gw; row < TROWS; row += NGW) {
        const int b = row / TB, rb = row - b * TB; const bool isctx = rb < CTXL;
        const bf16_t* src = QA + (size_t)row * NA_;
        const u32x4 qw = *(const u32x4*)(src + 8 * F.lane), kw = *(const u32x4*)(src + 512 + 8 * F.lane);
        const f32x4 q0 = {__uint_as_float(qw.x << 16), __uint_as_float(qw.x & 0xffff0000u), __uint_as_float(qw.y << 16), __uint_as_float(qw.y & 0xffff0000u)};
        const f32x4 q1 = {__uint_as_float(qw.z << 16), __uint_as_float(qw.z & 0xffff0000u), __uint_as_float(qw.w << 16), __uint_as_float(qw.w & 0xffff0000u)};
        const f32x4 k0 = {__uint_as_float(kw.x << 16), __uint_as_float(kw.x & 0xffff0000u), __uint_as_float(kw.y << 16), __uint_as_float(kw.y & 0xffff0000u)};
        const f32x4 k1 = {__uint_as_float(kw.z << 16), __uint_as_float(kw.z & 0xffff0000u), __uint_as_float(kw.w << 16), __uint_as_float(kw.w & 0xffff0000u)};
        const float pe = __uint_as_float((unsigned)src[1024 + F.lane] << 16);
        float sq = (q0.x * q0.x + q0.y * q0.y) + (q0.z * q0.z + q0.w * q0.w) + (q1.x * q1.x + q1.y * q1.y) + (q1.z * q1.z + q1.w * q1.w);
        float sk = (k0.x * k0.x + k0.y * k0.y) + (k0.z * k0.z + k0.w * k0.w) + (k1.x * k1.x + k1.y * k1.y) + (k1.z * k1.z + k1.w * k1.w);
        const float rq = rsqrtf(wave_sum(sq) * (1.0f / 512.0f) + EPS), rk = rsqrtf(wave_sum(sk) * (1.0f / 512.0f) + EPS);
        const f32x4 gq0 = *(const f32x4*)(p.q_norm + 8 * F.lane), gq1 = *(const f32x4*)(p.q_norm + 8 * F.lane + 4);
        const f32x4 gk0 = *(const f32x4*)(p.kv_norm + 8 * F.lane), gk1 = *(const f32x4*)(p.kv_norm + 8 * F.lane + 4);
        const f32x4 a0 = q0 * rq * gq0, a1 = q1 * rq * gq1, c0 = k0 * rk * gk0, c1 = k1 * rk * gk1;
        u32x4 o; o.x = pk2(a0.x, a0.y); o.y = pk2(a0.z, a0.w); o.z = pk2(a1.x, a1.y); o.w = pk2(a1.z, a1.w);
        *(u32x4*)(CQ + (size_t)row * 512 + 8 * F.lane) = o;
        o.x = pk2(c0.x, c0.y); o.y = pk2(c0.z, c0.w); o.z = pk2(c1.x, c1.y); o.w = pk2(c1.z, c1.w);
        *(u32x4*)(CKV + (size_t)row * 512 + 8 * F.lane) = o;
        const float other = __shfl_xor(pe, 1);
        float r = pe;
        if (!isctx) { const int s = rb - CTXL, gr = s >> 6, gc = s & 63; const int i = F.lane >> 1, f = i & 15; const int pos = i < 16 ? gr : gc;
            const f32x2 cs = rope[pos * 16 + f];
            r = (F.lane & 1) ? pe * cs.x + other * cs.y : pe * cs.x - other * cs.y; }
        const float rn = __shfl_xor(r, 1);
        if (!(F.lane & 1)) *(unsigned*)(KPE + (size_t)row * 64 + F.lane) = pk2(r, rn);
    }
}

__device__ __forceinline__ void phase_final(const Params& p, const Frame& F) {
    const int gw = F.vcu * NWAVES + F.wave, NGW = F.G * NWAVES;
    for (int row = gw; row < NBATCH * SEQ; row += NGW) {
        float* src = p.out + (size_t)row * DM;
        f32x4 v[8]; float ss = 0.f;
#pragma unroll
        for (int j = 0; j < 8; ++j) { v[j] = *(const f32x4*)(src + 4 * F.lane + 256 * j); ss += (v[j].x * v[j].x + v[j].y * v[j].y) + (v[j].z * v[j].z + v[j].w * v[j].w); }
        const float rstd = rsqrtf(wave_sum(ss) * (1.0f / DM) + EPS);
#pragma unroll
        for (int j = 0; j < 8; ++j) { const int c = 4 * F.lane + 256 * j; const f32x4 g = *(const f32x4*)(p.norm_final + c); *(f32x4*)(src + c) = v[j] * rstd * g; }
    }
}

using pg8::Unit; using pg8::HALF; using pg8::BM;
struct EpiQ {
    static constexpr bool PERM = true, AFTER_DRAIN = false;
    bf16_t* O; const f32x2* rope;
    __device__ __forceinline__ void operator()(const f32x4 (&acc)[2][2][4][2], const Unit& u, int wr, int wc, int fr, int fq) const {
        const int b = u.pm / 17, j = u.pm - b * 17; const bool latent = j > 0;
#pragma unroll
        for (int bj = 0; bj < 2; ++bj) {
            const int c32 = u.pn * BM + bj * HALF + wc * 32; const int hd = c32 / 192, off = c32 - hd * 192; const bool isrope = (off >= 128) && latent; const bool colrope = off == 160;
#pragma unroll
            for (int ai = 0; ai < 2; ++ai)
#pragma unroll
                for (int m = 0; m < 4; ++m) {
                    const int row = u.pm * BM + ai * HALF + wr * 64 + m * 16 + fr;
                    f32x4 v0 = acc[ai][bj][m][0], v1 = acc[ai][bj][m][1];
                    if (isrope) { const int gr = 4 * (j - 1) + 2 * ai + wr, gc = 16 * m + fr; const int pos = colrope ? gc : gr;
                        const f32x4 t0 = *(const f32x4*)(rope + pos * 16 + 4 * fq), t1 = *(const f32x4*)(rope + pos * 16 + 4 * fq + 2);
                        f32x4 w0, w1;
                        w0.x = v0.x * t0.x - v0.y * t0.y; w0.y = v0.y * t0.x + v0.x * t0.y; w0.z = v0.z * t0.z - v0.w * t0.w; w0.w = v0.w * t0.z + v0.z * t0.w;
                        w1.x = v1.x * t1.x - v1.y * t1.y; w1.y = v1.y * t1.x + v1.x * t1.y; w1.z = v1.z * t1.z - v1.w * t1.w; w1.w = v1.w * t1.z + v1.z * t1.w;
                        v0 = w0; v1 = w1; }
                    u32x4 w; w.x = pk2(v0[0], v0[1]); w.y = pk2(v0[2], v0[3]); w.z = pk2(v1[0], v1[1]); w.w = pk2(v1[2], v1[3]);
                    *(u32x4*)(O + (size_t)row * NQ + c32 + 8 * fq) = w; }
        }
    }
};
struct EpiRes {
    static constexpr bool PERM = false, AFTER_DRAIN = false;
    const float *src_lat, *src_ctx; float *dst_lat, *dst_ctx; const float* gate;
    __device__ __forceinline__ void operator()(const f32x4 (&acc)[2][2][4][2], const Unit& u, int wr, int wc, int fr, int fq) const {
        const int b = u.pm / 17, j = u.pm - b * 17; const bool isctx = j == 0;
        const size_t rbase = isctx ? (size_t)b * CTXL : (size_t)b * SEQ + (size_t)(j - 1) * 256;
        const float* sp = (isctx ? src_ctx : src_lat) + rbase * DM; float* dp = (isctx ? dst_ctx : dst_lat) + rbase * DM;
        const float* g = gate + (size_t)(isctx ? 4 : b) * 6 * DM;
        const int col0 = u.pn * BM + wc * 32 + 4 * fq;
        f32x4 gv[2][2];
#pragma unroll
        for (int bj = 0; bj < 2; ++bj)
#pragma unroll
            for (int n = 0; n < 2; ++n) gv[bj][n] = *(const f32x4*)(g + col0 + bj * HALF + n * 16);
#pragma unroll
        for (int ai = 0; ai < 2; ++ai)
#pragma unroll
            for (int m = 0; m < 4; ++m) { const size_t off = (size_t)(ai * HALF + wr * 64 + m * 16 + fr) * DM + col0;
#pragma unroll
                for (int bj = 0; bj < 2; ++bj)
#pragma unroll
                    for (int n = 0; n < 2; ++n) { const f32x4 r = *(const f32x4*)(sp + off + bj * HALF + n * 16); *(f32x4*)(dp + off + bj * HALF + n * 16) = r + gv[bj][n] * acc[ai][bj][m][n]; }
                asm volatile("" ::: "memory"); }
    }
};
struct EpiHeads128 {
    static constexpr bool PERM = true, AFTER_DRAIN = false;
    bf16_t* O;
    __device__ __forceinline__ void operator()(const f32x4 (&acc)[2][2][4][2], const Unit& u, int wr, int wc, int fr, int fq) const {
#pragma unroll
        for (int ai = 0; ai < 2; ++ai)
#pragma unroll
            for (int m = 0; m < 4; ++m) { const size_t row = (size_t)(u.pm * BM + ai * HALF + wr * 64 + m * 16 + fr);
#pragma unroll
                for (int bj = 0; bj < 2; ++bj) { const f32x4 v0 = acc[ai][bj][m][0], v1 = acc[ai][bj][m][1];
                    u32x4 w; w.x = pk2(v0[0], v0[1]); w.y = pk2(v0[2], v0[3]); w.z = pk2(v1[0], v1[1]); w.w = pk2(v1[2], v1[3]);
                    *(u32x4*)(O + ((size_t)(2 * u.pn + bj) * TROWS + row) * 128 + wc * 32 + 8 * fq) = w; } }
    }
};
struct EpiSwiglu {
    static constexpr bool PERM = true, AFTER_DRAIN = false;
    bf16_t* O;
    __device__ __forceinline__ void operator()(const f32x4 (&acc)[2][2][4][2], const Unit& u, int wr, int wc, int fr, int fq) const {
        const int col0 = u.pn * HALF + wc * 32 + 8 * fq;
#pragma unroll
        for (int ai = 0; ai < 2; ++ai)
#pragma unroll
            for (int m = 0; m < 4; ++m) { const int row = u.pm * BM + ai * HALF + wr * 64 + m * 16 + fr;
                f32x4 r0, r1;
#pragma unroll
                for (int e = 0; e < 4; ++e) { const float g0 = acc[ai][0][m][0][e], g1 = acc[ai][0][m][1][e];
                    r0[e] = g0 * __builtin_amdgcn_rcpf(1.0f + __expf(-g0)) * acc[ai][1][m][0][e]; r1[e] = g1 * __builtin_amdgcn_rcpf(1.0f + __expf(-g1)) * acc[ai][1][m][1][e]; }
                u32x4 w; w.x = pk2(r0[0], r0[1]); w.y = pk2(r0[2], r0[3]); w.z = pk2(r1[0], r1[1]); w.w = pk2(r1[2], r1[3]);
                *(u32x4*)(O + (size_t)row * DFF + col0) = w; }
    }
};
struct LatentOrder : pg8::StaticOrder {
    __device__ bool next(int i, Unit& u) const { if (!pg8::StaticOrder::next(i, u)) return false; u.pm = u.pm + (u.pm >> 4) + 1; return true; }
};

struct CtxSplitOrder {
    int nN, G, c, kbytes;
    __device__ void init(int N, int K, int G_, int c_) { nN = N / BM; G = G_; c = c_; kbytes = (K / NSPLIT) * 2; }
    __device__ bool next(int i, Unit& u) const { const int L = i * G + c; if (L >= 4 * nN * NSPLIT) return false; const int ks = L % NSPLIT, t = L / NSPLIT; u.pm = (t / nN) * 17; u.pn = t % nN; u.ko = ks * kbytes; return true; }
    __device__ __forceinline__ void a_ready(const Unit&) const {}
    __device__ __forceinline__ void done(const Unit&) const {}
};
struct EpiSlab {
    static constexpr bool PERM = false, AFTER_DRAIN = false;
    float* slab; int kbytes;
    __device__ __forceinline__ void operator()(const f32x4 (&acc)[2][2][4][2], const Unit& u, int wr, int wc, int fr, int fq) const {
        const int b = u.pm / 17, ks = u.ko / kbytes;
        float* dp = slab + ((size_t)ks * NBATCH * CTXL + (size_t)b * CTXL) * DM; const int col0 = u.pn * BM + wc * 32 + 4 * fq;
#pragma unroll
        for (int ai = 0; ai < 2; ++ai)
#pragma unroll
            for (int m = 0; m < 4; ++m) { const size_t off = (size_t)(ai * HALF + wr * 64 + m * 16 + fr) * DM + col0;
#pragma unroll
                for (int bj = 0; bj < 2; ++bj)
#pragma unroll
                    for (int n = 0; n < 2; ++n) *(f32x4*)(dp + off + bj * HALF + n * 16) = acc[ai][bj][m][n]; }
    }
};

struct QkvOrder : pg8::StaticOrder {
    __device__ bool next(int i, Unit& u) const {
        const long L = (long)i * G + c;
        if (L < nwg) { pg8::StaticOrder::next(i, u); u.pm = u.pm + (u.pm >> 4) + 1; return true; }
        const int t = (int)(L - nwg); if (t >= 64) return false;
        u.pm = (t >> 4) * 17; u.pn = 8 + (t & 15); return true; }
};

namespace att {
#define SBAR() __builtin_amdgcn_sched_barrier(0)
constexpr int QBLK = 32, KVBLK = 64, DV = 128;
constexpr float THR = 8.f;
template <int DQK> struct Sc { static constexpr float SCALE = DQK == 192 ? 0.07216878364870322f : 0.08838834764831845f; };
__device__ __forceinline__ int crow(int r, int hi) { return (r & 3) + 8 * (r >> 2) + 4 * hi; }
template <int DQK> __device__ __forceinline__ int kswz_x(int row) { return DQK == 192 ? (((row >> 1) & 7) << 4) : ((row & 7) << 4); }
template <int DQK> __device__ __forceinline__ int kswz(int row, int colB) { return row * (DQK * 2) + (colB ^ kswz_x<DQK>(row)); }

template <int DQK>
__device__ __forceinline__ void partialSM(f32x16& p0, f32x16& p1, float& m_reg, float& mn, float& alpha) {
    constexpr float SCALE = Sc<DQK>::SCALE; constexpr float C = SCALE * 1.4426950408889634f;
    float pmax = p0[0];
#pragma unroll
    for (int r = 1; r < 16; ++r) pmax = fmaxf(pmax, p0[r]);
#pragma unroll
    for (int r = 0; r < 16; ++r) pmax = fmaxf(pmax, p1[r]);
    { auto rr = __builtin_amdgcn_permlane32_swap(__float_as_uint(pmax), __float_as_uint(pmax), false, false);
      pmax = fmaxf(__uint_as_float(rr[0]), __uint_as_float(rr[1])); }
    if (__builtin_expect(__all(pmax - m_reg <= THR / SCALE), 1)) { mn = m_reg; alpha = 1.f; }
    else { mn = fmaxf(m_reg, pmax); alpha = __builtin_amdgcn_exp2f((m_reg - mn) * C); m_reg = mn; }
    const float mnC = -mn * C;
#pragma unroll
    for (int r = 0; r < 16; ++r) p0[r] = fmaf(p0[r], C, mnC);
#pragma unroll
    for (int r = 0; r < 16; ++r) p1[r] = fmaf(p1[r], C, mnC);
#pragma unroll
    for (int r = 0; r < 16; ++r) p0[r] = __builtin_amdgcn_exp2f(p0[r]);
}
__device__ __forceinline__ void finishSM(f32x16& p0, f32x16& p1, float alpha, float& l_reg, bf16x8& pa0, bf16x8& pa1, bf16x8& pa2, bf16x8& pa3) {
#pragma unroll
    for (int r = 0; r < 16; ++r) p1[r] = __builtin_amdgcn_exp2f(p1[r]);
    float ps = 0;
#pragma unroll
    for (int r = 0; r < 16; ++r) ps += p0[r];
#pragma unroll
    for (int r = 0; r < 16; ++r) ps += p1[r];
    { auto rr = __builtin_amdgcn_permlane32_swap(__float_as_uint(ps), __float_as_uint(ps), false, false);
      ps = __uint_as_float(rr[0]) + __uint_as_float(rr[1]); }
    l_reg = l_reg * alpha + ps;
#define PK4(P, BASE, OUT) do { unsigned a0 = pk2(P[BASE + 0], P[BASE + 1]), a1 = pk2(P[BASE + 2], P[BASE + 3]);   \
    unsigned b0 = pk2(P[BASE + 4], P[BASE + 5]), b1 = pk2(P[BASE + 6], P[BASE + 7]);                              \
    auto r0 = __builtin_amdgcn_permlane32_swap(a0, b0, false, false); auto r1 = __builtin_amdgcn_permlane32_swap(a1, b1, false, false); \
    u32x4 w = {r0[0], r1[0], r0[1], r1[1]}; OUT = *reinterpret_cast<bf16x8*>(&w); } while (0)
    PK4(p0, 0, pa0); PK4(p0, 8, pa1); PK4(p1, 0, pa2); PK4(p1, 8, pa3);
#undef PK4
}
template <int DQK>
__device__ __forceinline__ void qkt(f32x16& p0, f32x16& p1, const char* Ks, const bf16x8* qr, int kb0, int kb1, int kb2, int kb3) {
    p0 = f32x16{}; p1 = f32x16{};
#pragma unroll
    for (int d0 = 0; d0 < DQK / 16; ++d0) { const int kb = (d0 & 3) == 0 ? kb0 : (d0 & 3) == 1 ? kb1 : (d0 & 3) == 2 ? kb2 : kb3;
        const char* a = Ks + kb + (d0 >> 2) * 128;
        const bf16x8 b0 = *reinterpret_cast<const bf16x8*>(a);
        const bf16x8 b1 = *reinterpret_cast<const bf16x8*>(a + 32 * DQK * 2);
        p0 = __builtin_amdgcn_mfma_f32_32x32x16_bf16(b0, qr[d0], p0, 0, 0, 0);
        p1 = __builtin_amdgcn_mfma_f32_32x32x16_bf16(b1, qr[d0], p1, 0, 0, 0); }
}
__device__ __forceinline__ int v_st(int k, int c) { const int kk = (k & ~0xC) | ((k & 4) << 1) | ((k & 8) >> 1); return ((kk >> 3) * 4 + (c >> 5)) * 512 + ((kk & 7) * 32 + (c & 31)) * 2; }
__device__ __forceinline__ int v_rd_base(int lane) { return ((lane & 3) << 3) | (((lane >> 2) & 3) << 6) | (((lane >> 4) & 1) << 5) | (((lane >> 5) & 1) << 8); }
constexpr int v_rd_off(int d0, int ks, int half) { return d0 * 512 + ks * 4096 + half * 2048; }
template <int OFF> __device__ __forceinline__ s16x4 tr_read(int vb) {
    s16x4 r; asm volatile("ds_read_b64_tr_b16 %0, %1 offset:%2" : "=&v"(r) : "v"(vb), "i"(OFF) : "memory"); return r;
}
template <int D0> __device__ __forceinline__ void pv_one(f32x16& od, int vb, bf16x8 pa0, bf16x8 pa1, bf16x8 pa2, bf16x8 pa3) {
    const s16x4 l0 = tr_read<v_rd_off(D0, 0, 0)>(vb), h0 = tr_read<v_rd_off(D0, 0, 1)>(vb), l1 = tr_read<v_rd_off(D0, 1, 0)>(vb), h1 = tr_read<v_rd_off(D0, 1, 1)>(vb);
    const s16x4 l2 = tr_read<v_rd_off(D0, 2, 0)>(vb), h2 = tr_read<v_rd_off(D0, 2, 1)>(vb), l3 = tr_read<v_rd_off(D0, 3, 0)>(vb), h3 = tr_read<v_rd_off(D0, 3, 1)>(vb);
    asm volatile("s_waitcnt lgkmcnt(0)" ::: "memory"); SBAR();
#define PK(L, H) (bf16x8){L[0], L[1], L[2], L[3], H[0], H[1], H[2], H[3]}
    od = __builtin_amdgcn_mfma_f32_32x32x16_bf16(pa0, PK(l0, h0), od, 0, 0, 0);
    od = __builtin_amdgcn_mfma_f32_32x32x16_bf16(pa1, PK(l1, h1), od, 0, 0, 0);
    od = __builtin_amdgcn_mfma_f32_32x32x16_bf16(pa2, PK(l2, h2), od, 0, 0, 0);
    od = __builtin_amdgcn_mfma_f32_32x32x16_bf16(pa3, PK(l3, h3), od, 0, 0, 0);
#undef PK
}
__device__ __forceinline__ void pv_d0(f32x16* o, int vb, bf16x8 pa0, bf16x8 pa1, bf16x8 pa2, bf16x8 pa3) {
    pv_one<0>(o[0], vb, pa0, pa1, pa2, pa3); pv_one<1>(o[1], vb, pa0, pa1, pa2, pa3); pv_one<2>(o[2], vb, pa0, pa1, pa2, pa3); pv_one<3>(o[3], vb, pa0, pa1, pa2, pa3);
}
template <int DQK, bool DO_QK, bool DO_PV>
__device__ __forceinline__ void mstep(f32x16& p0, f32x16& p1, f32x16* o, const char* Ks, const bf16x8* qr, int kb0, int kb1, int kb2, int kb3,
                                      const char* Vs, bf16x8 pa0, bf16x8 pa1, bf16x8 pa2, bf16x8 pa3) {
    constexpr int ND = DQK / 16, W = 3;
    bf16x8 kf0[ND], kf1[ND]; s16x4 vl[16], vh[16];
    __builtin_amdgcn_s_setprio(1);
#define LDKF(d) do { const int kb_ = ((d) & 3) == 0 ? kb0 : ((d) & 3) == 1 ? kb1 : ((d) & 3) == 2 ? kb2 : kb3; const char* a_ = Ks + kb_ + ((d) >> 2) * 128; \
    kf0[d] = *reinterpret_cast<const bf16x8*>(a_); kf1[d] = *reinterpret_cast<const bf16x8*>(a_ + 32 * DQK * 2); } while (0)
#define LDVF(m) do { vl[m] = __builtin_amdgcn_ds_read_tr16_b64_v4i16((LAS s16x4*)(Vs + v_rd_off((m) >> 2, (m) & 3, 0))); vh[m] = __builtin_amdgcn_ds_read_tr16_b64_v4i16((LAS s16x4*)(Vs + v_rd_off((m) >> 2, (m) & 3, 1))); } while (0)
    if (DO_QK) { p0 = f32x16{}; p1 = f32x16{};
#pragma unroll
        for (int d = 0; d < W; ++d) LDKF(d);
#pragma unroll
        for (int d = 0; d < ND; ++d) {
            if (d + W < ND) LDKF(d + W); else if (DO_PV) LDVF(d + W - ND);
            SBAR();
            p0 = __builtin_amdgcn_mfma_f32_32x32x16_bf16(kf0[d], qr[d], p0, 0, 0, 0);
            p1 = __builtin_amdgcn_mfma_f32_32x32x16_bf16(kf1[d], qr[d], p1, 0, 0, 0);
            SBAR(); }
    } else {
#pragma unroll
        for (int m = 0; m < W; ++m) LDVF(m);
    }
    if (DO_PV) {
#pragma unroll
        for (int m = 0; m < 16; ++m) {
            if (m + W < 16) LDVF(m + W);
            SBAR();
            const bf16x8 vv = (bf16x8){vl[m][0], vl[m][1], vl[m][2], vl[m][3], vh[m][0], vh[m][1], vh[m][2], vh[m][3]};
            const bf16x8 pa = (m & 3) == 0 ? pa0 : (m & 3) == 1 ? pa1 : (m & 3) == 2 ? pa2 : pa3;
            o[m >> 2] = __builtin_amdgcn_mfma_f32_32x32x16_bf16(pa, vv, o[m >> 2], 0, 0, 0);
            SBAR(); }
    }
    __builtin_amdgcn_s_setprio(0);
#undef LDKF
#undef LDVF
}
struct NoMod { __device__ __forceinline__ void operator()(f32x16&, f32x16&, int, int, int, int) const {} };
struct NaMod {
    const float* btab;
    int r0, lo;
    __device__ __forceinline__ void operator()(f32x16& p0, f32x16& p1, int t, int wid, int r32, int hi) const {
        if (t < 4) return;
        const int kr = lo + t - 4, r = r0 + (wid >> 1); const int rs = min(max(r - 4, 0), 56); const bool vrow = kr >= rs && kr < rs + 8;
        const int c = (wid & 1) * 32 + r32, cs = min(max(c - 8, 0), 48); const int dr = vrow ? kr - r + 7 : 0;
        const float* bt = btab + dr * 31 + 15 - c;
#pragma unroll
        for (int g = 0; g < 16; ++g) { const int kc0 = crow(g, hi), kc1 = 32 + kc0;
            const bool ok0 = vrow && kc0 >= cs && kc0 < cs + 16, ok1 = vrow && kc1 >= cs && kc1 < cs + 16;
            const float b0 = bt[ok0 ? kc0 : c - 15], b1 = bt[ok1 ? kc1 : c - 15];
            p0[g] = ok0 ? p0[g] + b0 : -1e30f; p1[g] = ok1 ? p1[g] + b1 : -1e30f; }
    }
};

template <int DQK> struct Lds { static constexpr int SHM_V = KVBLK * DV * 2, SHM_K = KVBLK * DQK * 2, WS_OFF = 2 * SHM_V + 2 * SHM_K, BT_OFF = WS_OFF + 8 * 64 * 4, TOTAL = BT_OFF + 2048; };

template <int DQK, int LDQ, int LDK, int LDV, int LDO, int G, class Mod, int PRB = 0>
__device__ __forceinline__ void attn_body(const bf16_t* __restrict__ Qb, const bf16_t* __restrict__ Kn, const bf16_t* __restrict__ Kp, const bf16_t* __restrict__ Vh,
                                          bf16_t* __restrict__ Ob, int NT, int loff, const Mod& mod, char* lds) {
    constexpr int SHM_V = Lds<DQK>::SHM_V, SHM_K = Lds<DQK>::SHM_K; constexpr bool PE = DQK == 192;
    const int tid = threadIdx.x, wid = tid >> 6, lane = tid & 63, r32 = lane & 31, hi = lane >> 5;
    char* V_lds = lds; char* K_lds = lds + 2 * SHM_V;
    float* wsl = (float*)(lds + Lds<DQK>::WS_OFF) + wid * 64; float* li_l = wsl; float* al_l = wsl + 32;
    float m_reg = -1e30f, l_reg = 0; f32x16 o[4] = {}; bf16x8 qr[DQK / 16];
    const bf16_t* Qw = Qb + (long)(wid * QBLK + r32) * LDQ + hi * 8;
#pragma unroll
    for (int d0 = 0; d0 < DQK / 16; ++d0) qr[d0] = *reinterpret_cast<const bf16x8*>(Qw + d0 * 16);
    const int sr = tid >> 4, sc = (tid & 15) * 8, vst0 = v_st(sr, sc), vst1 = v_st(32 + sr, sc);
    const int pr = tid >> 3, pc = (tid & 7) * 8;
    const int vb0 = (int)(uintptr_t)V_lds + v_rd_base(lane);
    bf16x8 vs0 = {}, vs1 = {}, ks0 = {}, ks1 = {}, kp = {};
    const unsigned ko0 = (unsigned)(sr * LDK + sc), po0 = (unsigned)(pr * 64 + pc), vo0 = (unsigned)(sr * LDV + sc);
#define KROW(t) ((t) * KVBLK + ((t) >= 4 ? loff : 0))
#define KLOAD(t) do { if (PRB & 1) break; const bf16_t* kt_ = Kn + (size_t)KROW(t) * LDK; ks0 = *reinterpret_cast<const bf16x8*>(kt_ + ko0); ks1 = *reinterpret_cast<const bf16x8*>(kt_ + 32 * LDK + ko0); \
    if constexpr (PE) { const bf16_t* pt_ = Kp + (size_t)KROW(t) * 64; kp = *reinterpret_cast<const bf16x8*>(pt_ + po0); } } while (0)
#define VLOAD(t) do { if (PRB & 1) break; const bf16_t* vt_ = Vh + (size_t)KROW(t) * LDV; vs0 = *reinterpret_cast<const bf16x8*>(vt_ + vo0); vs1 = *reinterpret_cast<const bf16x8*>(vt_ + 32 * LDV + vo0); } while (0)
#define KWRITE(b) do { const int kc = sc * 2; *(bf16x8*)(K_lds + (b) * SHM_K + kswz<DQK>(sr, kc)) = ks0; *(bf16x8*)(K_lds + (b) * SHM_K + kswz<DQK>(32 + sr, kc)) = ks1; \
    if constexpr (PE) *(bf16x8*)(K_lds + (b) * SHM_K + kswz<DQK>(pr, 256 + pc * 2)) = kp; } while (0)
#define VWRITE(b) do { *(bf16x8*)(V_lds + (b) * SHM_V + vst0) = vs0; *(bf16x8*)(V_lds + (b) * SHM_V + vst1) = vs1; } while (0)
#define RESC(a) do { if (__any((a) < 1.f)) { if (hi == 0) al_l[r32] = (a); asm volatile("s_waitcnt lgkmcnt(0)" ::: "memory"); \
    _Pragma("unroll") for (int d = 0; d < 4; ++d) _Pragma("unroll") for (int r = 0; r < 16; ++r) o[d][r] *= al_l[crow(r, hi)]; } } while (0)
#define STAGE(s_) do { const int s__ = (s_), t__ = s__ >> 1; \
    if (!(s__ & 1)) { if (t__ + 1 < NT) KLOAD(t__ + 1); if (t__ < NT) VLOAD(t__); } \
    else { asm volatile("s_waitcnt vmcnt(0)" ::: "memory"); if (t__ + 1 < NT) KWRITE((t__ + 1) & 1); if (t__ < NT) VWRITE(t__ & 1); } } while (0)
#define SOFTMAX(t_) do { if (PRB & 2) break; mod(p0, p1, (t_), wid, r32, hi); partialSM<DQK>(p0, p1, m_reg, mn, al); RESC(al); finishSM(p0, p1, al, l_reg, pa0, pa1, pa2, pa3); } while (0)
    f32x16 p0 = {}, p1 = {}; float mn, al = 1.f; bf16x8 pa0 = {}, pa1 = {}, pa2 = {}, pa3 = {};
    int kb0 = kswz<DQK>(r32, 0 * 32 + hi * 16), kb1 = kswz<DQK>(r32, 1 * 32 + hi * 16), kb2 = kswz<DQK>(r32, 2 * 32 + hi * 16), kb3 = kswz<DQK>(r32, 3 * 32 + hi * 16);
    asm volatile("" : "+v"(kb0), "+v"(kb1), "+v"(kb2), "+v"(kb3));
#define PRE(s_) do { if (G == 1) STAGE(s_); } while (0)
#define POST(s_) do { if (G == 0) STAGE(s_); } while (0)
#define ABAR() do { asm volatile("s_waitcnt lgkmcnt(0)" ::: "memory"); __builtin_amdgcn_s_barrier(); asm volatile("" ::: "memory"); } while (0)
    KLOAD(0); asm volatile("s_waitcnt vmcnt(0)" ::: "memory"); KWRITE(0); ABAR();
    if (G == 1) { STAGE(0); ABAR(); }
    const char* Vrd = V_lds + v_rd_base(lane);
    PRE(G); SBAR(); if (!(PRB & 4)) mstep<DQK, true, false>(p0, p1, o, K_lds, qr, kb0, kb1, kb2, kb3, Vrd, pa0, pa1, pa2, pa3); POST(G); ABAR();
    for (int t = 0; t < NT - 1; ++t) {
        PRE(G + 2 * t + 1); SOFTMAX(t); POST(G + 2 * t + 1); ABAR();
        PRE(G + 2 * t + 2); SBAR(); if (!(PRB & 4)) mstep<DQK, true, true>(p0, p1, o, K_lds + ((t + 1) & 1) * SHM_K, qr, kb0, kb1, kb2, kb3, Vrd + (t & 1) * SHM_V, pa0, pa1, pa2, pa3); SBAR(); POST(G + 2 * t + 2); ABAR();
    }
    PRE(G + 2 * NT - 1); SOFTMAX(NT - 1); POST(G + 2 * NT - 1); ABAR();
    SBAR(); if (!(PRB & 4)) mstep<DQK, false, true>(p0, p1, o, K_lds, qr, kb0, kb1, kb2, kb3, Vrd + ((NT - 1) & 1) * SHM_V, pa0, pa1, pa2, pa3); ABAR();
    if (G == 0) { ABAR(); }
#undef ABAR
#undef PRE
#undef POST
#undef STAGE
#undef SOFTMAX
    if (hi == 0) li_l[r32] = l_reg; asm volatile("s_waitcnt lgkmcnt(0)" ::: "memory");
    int lane_e = lane; asm volatile("" : "+v"(lane_e));
    const int r32e = lane_e & 31, hie = lane_e >> 5;
    bf16_t* Ow = Ob + (long)(wid * QBLK + 4 * hie) * LDO + r32e;
#pragma unroll
    for (int r = 0; r < 16; ++r) { const int orow = (r & 3) + 8 * (r >> 2); const float rl = __builtin_amdgcn_rcpf(li_l[orow + 4 * hie]);
#pragma unroll
        for (int d0 = 0; d0 < 4; ++d0) { const unsigned w = pk2(o[d0][r] * rl, 0.f); Ow[(long)orow * LDO + d0 * 32] = (bf16_t)(w & 0xffffu); } }
#undef KROW
#undef KLOAD
#undef VLOAD
#undef KWRITE
#undef VWRITE
#undef RESC
}

struct NoMod2 { __device__ __forceinline__ void operator()(f32x16& p, int, int, int, int, int) const { p = f32x16{}; } };
struct NaMod2 {
    const float* btab; int r0, lo;
    __device__ __forceinline__ void operator()(f32x16& p, int t, int hf, int wid, int r32, int hi) const {
        if (t < 4) { p = f32x16{}; return; }
        const int kr = lo + t - 4, r = r0 + (wid >> 1); const int rs = min(max(r - 4, 0), 56);
        if (!(kr >= rs && kr < rs + 8)) {
#pragma unroll
            for (int g = 0; g < 16; ++g) p[g] = -1e30f;
            return; }
        const int c = (wid & 1) * 32 + r32, cs = min(max(c - 8, 0), 48);
        const int d = 4 * hi + 32 * hf - cs;
        const float* bt = btab + (kr - r + 7) * 31 + 15 - c + 4 * hi + 32 * hf;
#pragma unroll
        for (int g = 0; g < 16; ++g) { const int K0 = (g & 3) + 8 * (g >> 2); const bool ok = (unsigned)(K0 + d) < 16u; const float bv = bt[K0]; p[g] = ok ? bv : -1e30f; }
    }
};
__device__ __forceinline__ float max3f(float a, float b, float c) { return __builtin_fmaxf(__builtin_fmaxf(a, b), c); }
#define PK4V(P, BASE, OUT) do { unsigned a0 = pk2(P[BASE + 0], P[BASE + 1]), a1 = pk2(P[BASE + 2], P[BASE + 3]);   \
    unsigned b0 = pk2(P[BASE + 4], P[BASE + 5]), b1 = pk2(P[BASE + 6], P[BASE + 7]);                              \
    auto r0 = __builtin_amdgcn_permlane32_swap(a0, b0, false, false); auto r1 = __builtin_amdgcn_permlane32_swap(a1, b1, false, false); \
    u32x4 w = {r0[0], r1[0], r0[1], r1[1]}; OUT = *reinterpret_cast<bf16x8*>(&w); } while (0)

template <int DQK, int HFK, int HFV, bool DO_QK, bool DO_SM, bool DO_PV, class Mod>
__device__ __forceinline__ void region(f32x16& pn, f32x16& pc, bf16x8 pal, bf16x8 pah, bf16x8& pbl, bf16x8& pbh, f32x16* o, float& m_reg, float& l_reg, float& al,
                                       const LAS char* Kb, const bf16x8* qr, int kb0, int kb1, int kb2, int kb3, const LAS char* Vrd, const Mod& mod, int tmod, int hfmod, int wid, int r32, int hi, const char* Qpe, int qx) {
    constexpr int ND = DQK / 16, NQ = DO_QK ? ND : 0, NP = DO_PV ? 8 : 0, NM = NQ + NP, W = (DQK == 192 ? 2 : 3), NS = 10;
    constexpr float SCALE = Sc<DQK>::SCALE, C = SCALE * 1.4426950408889634f, THRS = THR / SCALE;
    bf16x8 kf[ND]; s16x4 vl[8], vh[8];
    float t0 = 0.f, t1 = 0.f, t2 = 0.f, t3 = 0.f, t4 = 0.f, pmax = 0.f, mnC = 0.f, ps = 0.f;
#define LDF(j) do { if ((j) < NQ) { const int kb_ = ((j) & 3) == 0 ? kb0 : ((j) & 3) == 1 ? kb1 : ((j) & 3) == 2 ? kb2 : kb3; \
        kf[(j) < NQ ? (j) : 0] = *reinterpret_cast<const LAS bf16x8*>(Kb + kb_ + ((j) >> 2) * 128 + HFK * 32 * DQK * 2); } \
    else { constexpr int m_ = (j) - NQ >= 0 ? ((j) - NQ) & 7 : 0; \
        vl[m_] = __builtin_amdgcn_ds_read_tr16_b64_v4i16((LAS s16x4*)(LAS char*)(Vrd + v_rd_off(m_ >> 1, 2 * HFV + (m_ & 1), 0))); \
        vh[m_] = __builtin_amdgcn_ds_read_tr16_b64_v4i16((LAS s16x4*)(LAS char*)(Vrd + v_rd_off(m_ >> 1, 2 * HFV + (m_ & 1), 1))); } } while (0)
#define MMF(j) do { if ((j) < NQ) { pn = __builtin_amdgcn_mfma_f32_32x32x16_bf16(kf[(j) < NQ ? (j) : 0], qr[(j) < NQ ? (j) : 0], pn, 0, 0, 0); } \
    else { constexpr int m_ = (j) - NQ >= 0 ? ((j) - NQ) & 7 : 0; const bf16x8 vv_ = (bf16x8){vl[m_][0], vl[m_][1], vl[m_][2], vl[m_][3], vh[m_][0], vh[m_][1], vh[m_][2], vh[m_][3]}; \
        o[m_ >> 1] = __builtin_amdgcn_mfma_f32_32x32x16_bf16((m_ & 1) ? pah : pal, vv_, o[m_ >> 1], 0, 0, 0); } } while (0)
    if (DO_QK) mod(pn, tmod, hfmod, wid, r32, hi);
    [&]<int... J>(std::integer_sequence<int, J...>) { ((J < NM && J < W ? (void)([&] { LDF(J); }()) : (void)0), ...); }(std::make_integer_sequence<int, 3>{});
    [&]<int... S>(std::integer_sequence<int, S...>) {
        (([&] {
            constexpr int jb = S * NM / NS, je = (S + 1) * NM / NS;
            [&]<int... Q>(std::integer_sequence<int, Q...>) {
                (([&] { constexpr int j = jb + Q; if constexpr (j < je) { if constexpr (j + W < NM) { LDF(j + W); } MMF(j); } }()), ...);
            }(std::make_integer_sequence<int, 3>{});
            if constexpr (DO_SM) {
                if constexpr (S == 0) { t0 = max3f(pc[0], pc[1], pc[2]); t1 = max3f(pc[3], pc[4], pc[5]); t2 = max3f(pc[6], pc[7], pc[8]); }
                if constexpr (S == 1) { t3 = max3f(pc[9], pc[10], pc[11]); t4 = max3f(pc[12], pc[13], pc[14]); t0 = max3f(t0, t1, pc[15]); t2 = max3f(t2, t3, t4); pmax = fmaxf(t0, t2);
                    auto rr = __builtin_amdgcn_permlane32_swap(__float_as_uint(pmax), __float_as_uint(pmax), false, false); pmax = fmaxf(__uint_as_float(rr[0]), __uint_as_float(rr[1])); }
                if constexpr (S == 2) { const bool keep = __all(pmax - m_reg <= THRS); const float mn = keep ? m_reg : fmaxf(m_reg, pmax); al = __builtin_amdgcn_exp2f((m_reg - mn) * C); m_reg = mn; mnC = -mn * C; }
                if constexpr (S >= 3 && S <= 6) {
#pragma unroll
                    for (int r = 4 * (S - 3); r < 4 * (S - 3) + 4; ++r) pc[r] = __builtin_amdgcn_exp2f(fmaf(pc[r], C, mnC)); }
                if constexpr (S == 7) { ps = ((pc[0] + pc[1]) + (pc[2] + pc[3])) + ((pc[4] + pc[5]) + (pc[6] + pc[7])) + (((pc[8] + pc[9]) + (pc[10] + pc[11])) + ((pc[12] + pc[13]) + (pc[14] + pc[15]))); }
                if constexpr (S == 8) { auto rr = __builtin_amdgcn_permlane32_swap(__float_as_uint(ps), __float_as_uint(ps), false, false); ps = __uint_as_float(rr[0]) + __uint_as_float(rr[1]);
                    l_reg = l_reg * al + ps; PK4V(pc, 0, pbl); }
                if constexpr (S == 9) { PK4V(pc, 8, pbh); }
            }
            SBAR();
        }()), ...);
    }(std::make_integer_sequence<int, NS>{});
#undef LDF
#undef MMF
}

template <int DQK, int LDQ, int LDK, int LDV, int LDO, class Mod>
__device__ __forceinline__ void attn_body2(const bf16_t* __restrict__ Qb, const bf16_t* __restrict__ Kn, const bf16_t* __restrict__ Kp, const bf16_t* __restrict__ Vh,
                                           bf16_t* __restrict__ Ob, int NT, int loff, const Mod& mod, char* lds, const int tid) {
    constexpr int SHM_V = Lds<DQK>::SHM_V, SHM_K = Lds<DQK>::SHM_K; constexpr bool PE = DQK == 192;
    const int wid = __builtin_amdgcn_readfirstlane(tid >> 6), lane = tid & 63, r32 = lane & 31, hi = lane >> 5;
    LAS char* V_lds = (LAS char*)lds; LAS char* K_lds = V_lds + 2 * SHM_V;
    float* wsl = (float*)(lds + Lds<DQK>::WS_OFF) + wid * 64; float* li_l = wsl; float* al_l = wsl + 32;
    float m_reg = -1e30f, l_reg = 0; f32x16 o[4] = {}; bf16x8 qr[DQK / 16];
    const bf16_t* Qw = Qb + (long)(wid * QBLK + r32) * LDQ + hi * 8;
#pragma unroll
    for (int d0 = 0; d0 < DQK / 16; ++d0) qr[d0] = *reinterpret_cast<const bf16x8*>(Qw + d0 * 16);
    const int qx = 0; const char* Qpe = lds;
    const int sr = tid >> 4, sc = (tid & 15) * 8, vst0 = v_st(sr, sc), vst1 = vst0 + 8192;
    const int pr = tid >> 3, pc_ = (tid & 7) * 8;
    bf16x8 vs0 = {}, vs1 = {}, ks0 = {}, ks1 = {}, kp = {};
    const int kw0 = kswz<DQK>(sr, sc * 2), kwp = kswz<DQK>(pr, 256 + pc_ * 2);
    const unsigned ko0 = (unsigned)(sr * LDK + sc), po0 = (unsigned)(pr * 64 + pc_), vo0 = (unsigned)(sr * LDV + sc);
#define KROW(t) ((t) * KVBLK + ((t) >= 4 ? loff : 0))
#define KLOAD(t) do { const bf16_t* kt_ = Kn + (size_t)KROW(t) * LDK; ks0 = *reinterpret_cast<const bf16x8*>(kt_ + ko0); ks1 = *reinterpret_cast<const bf16x8*>(kt_ + 32 * LDK + ko0); \
    if constexpr (PE) { const bf16_t* pt_ = Kp + (size_t)KROW(t) * 64; kp = *reinterpret_cast<const bf16x8*>(pt_ + po0); } } while (0)
#define VLOAD(t) do { const bf16_t* vt_ = Vh + (size_t)KROW(t) * LDV; vs0 = *reinterpret_cast<const bf16x8*>(vt_ + vo0); vs1 = *reinterpret_cast<const bf16x8*>(vt_ + 32 * LDV + vo0); } while (0)
#define KWRITE(b) do { *(LAS bf16x8*)(K_lds + (b) * SHM_K + kw0) = ks0; *(LAS bf16x8*)(K_lds + (b) * SHM_K + kw0 + 32 * DQK * 2) = ks1; \
    if constexpr (PE) *(LAS bf16x8*)(K_lds + (b) * SHM_K + kwp) = kp; } while (0)
#define VWRITE(b) do { *(LAS bf16x8*)(V_lds + (b) * SHM_V + vst0) = vs0; *(LAS bf16x8*)(V_lds + (b) * SHM_V + vst1) = vs1; } while (0)
#define RESC(a) do { if (__any((a) < 1.f)) { if (hi == 0) al_l[r32] = (a); asm volatile("s_waitcnt lgkmcnt(0)" ::: "memory"); \
    _Pragma("unroll") for (int d = 0; d < 4; ++d) _Pragma("unroll") for (int r = 0; r < 16; ++r) o[d][r] *= al_l[crow(r, hi)]; } } while (0)
#define ABAR() do { asm volatile("s_waitcnt lgkmcnt(0)" ::: "memory"); __builtin_amdgcn_s_barrier(); asm volatile("" ::: "memory"); } while (0)
    int kb0 = kswz<DQK>(r32, 0 * 32 + hi * 16), kb1 = kswz<DQK>(r32, 1 * 32 + hi * 16), kb2 = kswz<DQK>(r32, 2 * 32 + hi * 16), kb3 = kswz<DQK>(r32, 3 * 32 + hi * 16);
    asm volatile("" : "+v"(kb0), "+v"(kb1), "+v"(kb2), "+v"(kb3));
    const LAS char* Vrd = V_lds + v_rd_base(lane);
    f32x16 P0 = {}, P1 = {}; bf16x8 A0l = {}, A0h = {}, A1l = {}, A1h = {}; float al = 1.f;
#define RA(...) __VA_ARGS__, wid, r32, hi, Qpe, qx
    KLOAD(0); VLOAD(0); asm volatile("s_waitcnt vmcnt(0)" ::: "memory"); KWRITE(0); VWRITE(0); KLOAD(1); ABAR();
    region<DQK, 0, 0, true, false, false, Mod>(P0, P1, A1l, A1h, A0l, A0h, o, m_reg, l_reg, al, K_lds, qr, kb0, kb1, kb2, kb3, Vrd, RA(mod, 0, 0));
    asm volatile("s_waitcnt vmcnt(0)" ::: "memory"); KWRITE(1); VLOAD(1);
    region<DQK, 1, 1, true, true, false, Mod>(P1, P0, A1l, A1h, A0l, A0h, o, m_reg, l_reg, al, K_lds, qr, kb0, kb1, kb2, kb3, Vrd, RA(mod, 0, 1));
    RESC(al); ABAR();
    asm volatile("s_waitcnt vmcnt(0)" ::: "memory"); VWRITE(1); if (2 < NT) KLOAD(2);
    region<DQK, 0, 0, true, true, true, Mod>(P0, P1, A0l, A0h, A1l, A1h, o, m_reg, l_reg, al, K_lds + SHM_K, qr, kb0, kb1, kb2, kb3, Vrd, RA(mod, 1, 0));
    RESC(al);
    for (int t = 1; t < NT - 1; ++t) {
        VLOAD(t + 1);
        region<DQK, 1, 1, true, true, true, Mod>(P1, P0, A1l, A1h, A0l, A0h, o, m_reg, l_reg, al, K_lds + (t & 1) * SHM_K, qr, kb0, kb1, kb2, kb3, Vrd + ((t - 1) & 1) * SHM_V, RA(mod, t, 1));
        asm volatile("s_waitcnt vmcnt(2)" ::: "memory"); KWRITE((t + 1) & 1);
        RESC(al); ABAR();
        asm volatile("s_waitcnt vmcnt(0)" ::: "memory"); VWRITE((t + 1) & 1); if (t + 2 < NT) KLOAD(t + 2);
        region<DQK, 0, 0, true, true, true, Mod>(P0, P1, A0l, A0h, A1l, A1h, o, m_reg, l_reg, al, K_lds + ((t + 1) & 1) * SHM_K, qr, kb0, kb1, kb2, kb3, Vrd + (t & 1) * SHM_V, RA(mod, t + 1, 0));
        RESC(al);
    }
    { const int t = NT - 1;
      region<DQK, 1, 1, true, true, true, Mod>(P1, P0, A1l, A1h, A0l, A0h, o, m_reg, l_reg, al, K_lds + (t & 1) * SHM_K, qr, kb0, kb1, kb2, kb3, Vrd + ((t - 1) & 1) * SHM_V, RA(mod, t, 1));
      RESC(al); ABAR();
      region<DQK, 0, 0, false, true, true, Mod>(P0, P1, A0l, A0h, A1l, A1h, o, m_reg, l_reg, al, K_lds, qr, kb0, kb1, kb2, kb3, Vrd + (t & 1) * SHM_V, RA(mod, t, 1));
      RESC(al);
      region<DQK, 0, 1, false, false, true, Mod>(P0, P1, A1l, A1h, A0l, A0h, o, m_reg, l_reg, al, K_lds, qr, kb0, kb1, kb2, kb3, Vrd + (t & 1) * SHM_V, RA(mod, t, 1)); }
#undef RA
    if (hi == 0) li_l[r32] = l_reg; asm volatile("s_waitcnt lgkmcnt(0)" ::: "memory");
    int lane_e = lane; asm volatile("" : "+v"(lane_e));
    const int r32e = lane_e & 31, hie = lane_e >> 5;
    bf16_t* Ow = Ob + (long)(wid * QBLK + 4 * hie) * LDO + r32e;
#pragma unroll
    for (int r = 0; r < 16; ++r) { const int orow = (r & 3) + 8 * (r >> 2); const float rl = __builtin_amdgcn_rcpf(li_l[orow + 4 * hie]);
#pragma unroll
        for (int d0 = 0; d0 < 4; ++d0) { const unsigned w = pk2(o[d0][r] * rl, 0.f); Ow[(long)orow * LDO + d0 * 32] = (bf16_t)(w & 0xffffu); } }
#undef KROW
#undef KLOAD
#undef VLOAD
#undef KWRITE
#undef VWRITE
#undef RESC
#undef ABAR
}
}

#ifndef ATT_V2_MLA
#define ATT_V2_MLA 1
#endif
#ifndef ATT_V2_NA
#define ATT_V2_NA 1
#endif
#ifndef MLA_SDEPTH
#define MLA_SDEPTH 1
#endif
template <int PRB = 0>
__device__ __forceinline__ void phase_mla_attn(const Params& p, const Frame& F, unsigned char* lds) {
    const bf16_t* Q = (const bf16_t*)(p.ws + WS_Q); const bf16_t* KV = (const bf16_t*)(p.ws + WS_KV); const bf16_t* KPE = (const bf16_t*)(p.ws + WS_KPE);
    bf16_t* O = (bf16_t*)(p.ws + (PRB ? WS_END : WS_H));
    for (int u = F.vcu; u < 1024 + 64; u += F.G) {
        int b, h, qrow, NT;
        if (u < 1024) { const int bh = u >> 4, qt = u & 15; b = bh >> 4; h = bh & 15; qrow = b * TB + CTXL + qt * 256; NT = TB / 64; }
        else { const int cu = u - 1024; b = cu >> 4; h = cu & 15; qrow = b * TB; NT = CTXL / 64; }
        const size_t brow = (size_t)b * TB;
        __syncthreads();
#if ATT_V2_MLA
        att::attn_body2<192, NQ, 256, 256, DM, att::NoMod2>(Q + (size_t)qrow * NQ + h * 192, KV + ((size_t)h * TROWS + brow) * 256, KPE + brow * 64, KV + ((size_t)h * TROWS + brow) * 256 + 128, O + (size_t)qrow * DM + h * 128, NT, 0, att::NoMod2{}, (char*)lds, F.tid);
#else
        if (F.wave < 4) att::attn_body<192, NQ, NKV, NKV, DM, 0, att::NoMod, PRB>(Q + (size_t)qrow * NQ + h * 192, KV + brow * NKV + h * 256, KPE + brow * 64, KV + brow * NKV + h * 256 + 128, O + (size_t)qrow * DM + h * 128, NT, 0, att::NoMod{}, (char*)lds);
        else att::attn_body<192, NQ, NKV, NKV, DM, 1, att::NoMod, PRB>(Q + (size_t)qrow * NQ + h * 192, KV + brow * NKV + h * 256, KPE + brow * 64, KV + brow * NKV + h * 256 + 128, O + (size_t)qrow * DM + h * 128, NT, 0, att::NoMod{}, (char*)lds);
#endif
    }
}
__device__ __forceinline__ void phase_na_attn(const Params& p, const Frame& F, unsigned char* lds) {
    const bf16_t* QKV = (const bf16_t*)(p.ws + WS_Q); bf16_t* O = (bf16_t*)(p.ws + WS_H);
    float* btab = (float*)(lds + att::Lds<128>::BT_OFF);
    for (int u = F.vcu; u < 1024; u += F.G) {
        const int bh = u >> 4, g = u & 15, b = bh >> 4, h = bh & 15, r0 = 4 * g;
        int lo = min(max(r0 - 4, 0), 56), hi_ = min(max(r0 - 1, 0), 56) + 8;
        const int NT = 4 + (hi_ - lo);
        const size_t brow = (size_t)b * TB; const int qrow = b * TB + CTXL + r0 * 64;
        __syncthreads();
        if (F.tid < 15 * 31) btab[F.tid] = p.na_bias[h * (15 * 31) + F.tid] * (1.0f / att::Sc<128>::SCALE);
#if ATT_V2_NA
        att::NaMod2 mod2{btab, r0, lo};
        att::attn_body2<128, 128, 128, 128, DM, att::NaMod2>(QKV + ((size_t)h * TROWS + qrow) * 128, QKV + ((size_t)(16 + h) * TROWS + brow) * 128, nullptr, QKV + ((size_t)(32 + h) * TROWS + brow) * 128, O + (size_t)qrow * DM + h * 128, NT, lo * 64, mod2, (char*)lds, F.tid);
#else
        att::NaMod mod{btab, r0, lo};
        if (F.wave < 4) att::attn_body<128, NQKV, NQKV, NQKV, DM, 0, att::NaMod>(QKV + (size_t)qrow * NQKV + h * 128, QKV + brow * NQKV + DM + h * 128, nullptr, QKV + brow * NQKV + 2 * DM + h * 128, O + (size_t)qrow * DM + h * 128, NT, lo * 64, mod, (char*)lds);
        else att::attn_body<128, NQKV, NQKV, NQKV, DM, 1, att::NaMod>(QKV + (size_t)qrow * NQKV + h * 128, QKV + brow * NQKV + DM + h * 128, nullptr, QKV + brow * NQKV + 2 * DM + h * 128, O + (size_t)qrow * DM + h * 128, NT, lo * 64, mod, (char*)lds);
#endif
    }
}

#define XB_TMO      128
#define XB_XCNT(j)  (256  + 64 * (j))
#define XB_XSUB(j)  (1280 + 64 * (j))
#define XB_XGEN(j)  (2304 + 64 * (j))
#define XB_TOP      3328
#define XB_TOPGEN   3392
#define XCD_BAR_WORDS 3456
#define XB_SPIN_CAP (1u << 18)

__device__ __forceinline__ unsigned xb_ld(unsigned* p)              { return __hip_atomic_load(p, __ATOMIC_RELAXED, __HIP_MEMORY_SCOPE_AGENT); }
__device__ __forceinline__ unsigned xb_add(unsigned* p, unsigned v) { return __hip_atomic_fetch_add(p, v, __ATOMIC_RELAXED, __HIP_MEMORY_SCOPE_AGENT); }
__device__ __forceinline__ unsigned xb_xcc_id() { return (unsigned)__builtin_amdgcn_s_getreg((3 << 11) | 20) & 0xFu; }
#define XB_SPIN(cond, bar) do { unsigned _sp = 0; while (cond) { __builtin_amdgcn_s_sleep(1); \
    if ((++_sp & 255u) == 0u) { if (xb_ld(&(bar)[XB_TMO])) break; if (_sp > XB_SPIN_CAP) { atomicAdd(&(bar)[XB_TMO], 1u); break; } } } } while (0)

struct XcdBarrier {
    unsigned* bar; unsigned x;
    volatile LAS unsigned* st;
};

__device__ __forceinline__ XcdBarrier xcd_barrier_post(unsigned* bar, volatile LAS unsigned* st) {
    XcdBarrier b; b.bar = bar; b.x = xb_xcc_id(); b.st = st;
    if (threadIdx.x == 0) (void)xb_add(&bar[XB_XCNT(b.x)], 1u);
    return b;
}
__device__ __forceinline__ void xcd_barrier_complete(unsigned* bar, unsigned x, unsigned& nloc, unsigned& nx) {
    const unsigned G = gridDim.x * gridDim.y * gridDim.z;
    unsigned sum, cnt, mine, sp = 0u;
    for (;;) {
        sum = 0u; cnt = 0u; mine = 0u;
#pragma unroll
        for (unsigned j = 0; j < 16; ++j) { const unsigned c = xb_ld(&bar[XB_XCNT(j)]); sum += c; cnt += (c > 0u) ? 1u : 0u; mine = (j == x) ? c : mine; }
        if (sum == G) break;
        __builtin_amdgcn_s_sleep(1);
        if ((++sp & 255u) == 0u) { if (xb_ld(&bar[XB_TMO])) break; if (sp > XB_SPIN_CAP) { atomicAdd(&bar[XB_TMO], 1u); break; } }
    }
    nloc = mine > 0u ? mine : 1u; nx = cnt > 0u ? cnt : 1u;
}

__device__ __forceinline__ void xcd_barrier(const XcdBarrier& b, const bool leader_thread) {
    asm volatile("s_waitcnt vmcnt(0)" ::: "memory");
    __syncthreads();
    if (leader_thread) {
        unsigned* bar = b.bar;
        __builtin_amdgcn_s_waitcnt(0);
        unsigned nloc = b.st[0], nx = b.st[1];
        if (nloc == 0u) { xcd_barrier_complete(bar, b.x, nloc, nx); b.st[0] = nloc; b.st[1] = nx; }
        const unsigned old = xb_add(&bar[XB_XSUB(b.x)], 1u);
        const unsigned gen = old / nloc;
        if (old + 1u == (gen + 1u) * nloc) {
            __builtin_amdgcn_fence(__ATOMIC_RELEASE, "agent");
            asm volatile("s_waitcnt vmcnt(0)" ::: "memory");
            const unsigned og = xb_add(&bar[XB_TOP], 1u);
            const unsigned tg = og / nx;
            if (og + 1u == (tg + 1u) * nx) xb_add(&bar[XB_TOPGEN], 1u);
            else XB_SPIN(xb_ld(&bar[XB_TOPGEN]) == tg, bar);
            __builtin_amdgcn_fence(__ATOMIC_ACQUIRE, "agent");
            xb_add(&bar[XB_XGEN(b.x)], 1u);
            asm volatile("s_waitcnt vmcnt(0)" ::: "memory");
        } else {
            XB_SPIN(xb_ld(&bar[XB_XGEN(b.x)]) == gen, bar);
            __builtin_amdgcn_fence(__ATOMIC_ACQUIRE, "agent");
            asm volatile("s_waitcnt vmcnt(0)" ::: "memory");
        }
    }
    __syncthreads();
}


constexpr int NPHASES = 18;
__device__ __forceinline__ Params load_params() {
    const __attribute__((address_space(4))) Params* q = (const __attribute__((address_space(4))) Params*)__builtin_amdgcn_kernarg_segment_ptr();
    asm volatile("" : "+s"(q)); Params r; __builtin_memcpy(&r, (const void*)q, sizeof(Params)); return r;
}
#define PL load_params()
__global__ void __launch_bounds__(NTHREADS) mega_fwd(Params p) {
    __builtin_assume(__builtin_amdgcn_workitem_id_y() == 0); __builtin_assume(__builtin_amdgcn_workitem_id_z() == 0);
    extern __shared__ __attribute__((aligned(16))) unsigned char lds_raw[];
    LAS unsigned char* lds = (LAS unsigned char*)lds_raw;
    const int wave_s = __builtin_amdgcn_readfirstlane((int)threadIdx.x >> 6);
#define MKFRAME() Frame F; { int ln_; asm volatile("v_mbcnt_lo_u32_b32 %0, -1, 0\n\tv_mbcnt_hi_u32_b32 %0, -1, %0" : "=v"(ln_)); F.lane = ln_; F.wave = wave_s; F.tid = wave_s * 64 + ln_; \
    F.G = gridDim.x; const int bx = blockIdx.x; F.vcu = (F.G % 8 == 0) ? (bx % 8) * (F.G / 8) + bx / 8 : bx; }
    cg::grid_group grid = cg::this_grid();
    unsigned char* ws = p.ws; asm volatile("" : "+s"(ws));
    const int lo = p.ph_lo, hi = p.ph_hi;
    float* XC = (float*)(ws + WS_XC); const float* MOD = (const float*)(ws + WS_MOD);
#ifndef PHASE_MASK
#define PHASE_MASK 0x3ffff
#endif
#define IN(k) (((PHASE_MASK >> (k)) & 1) && lo <= (k) && (k) < hi)
    volatile LAS unsigned* bst = (volatile LAS unsigned*)(lds + LDS_BYTES - 16);
    if (threadIdx.x < 4) bst[threadIdx.x] = 0u;
    __syncthreads();
    if (blockIdx.x == 0) { for (int i = threadIdx.x; i < 16384 / 16; i += NTHREADS) ((u32x4*)(ws + WS_CTL))[i] = (u32x4){0u, 0u, 0u, 0u}; __threadfence(); }
    if (hi - lo > 1) grid.sync();
    const XcdBarrier xbar = xcd_barrier_post((unsigned*)(ws + WS_CTL), bst);
#define GRID_BAR() do { const bool ldr_ = (wave_s == 0) && (__builtin_amdgcn_mbcnt_hi(~0u, __builtin_amdgcn_mbcnt_lo(~0u, 0u)) == 0u); xcd_barrier(xbar, ldr_); } while (0)
#define SEAM(k) do { if (IN(k) && IN((k) + 1)) GRID_BAR(); } while (0)

#ifndef DBL_MASK
#define DBL_MASK 0
#endif
#define DBL(k) ((DBL_MASK >> (k)) & 1)
#ifndef PRB_VAR
#define PRB_VAR 0
#endif
    if (IN(0)) { MKFRAME(); phase0(PL, F, lds); if (DBL(0)) { GRID_BAR(); phase0(PL, F, lds); } } SEAM(0);
    if (IN(1)) { MKFRAME(); phase_norm<true>(PL, F, 0, 0, false); } SEAM(1);
    if (IN(2)) { MKFRAME();
        pg8::Gemm g{(const bf16_t*)(ws + WS_H), (const bf16_t*)(ws + WS_WA), TROWS, NA_, DM, DM}; pg8::StaticOrder S; S.init(TROWS, NA_, F.G, (int)blockIdx.x);
        pg8::EpiBf16<0> E{(bf16_t*)(ws + WS_QA), NA_, nullptr, 0, 0};
        pg8::gemm_phase<pg8::EpiBf16<0>, pg8::StaticOrder, false>(lds, g, S, E, nullptr, F.tid);
    } SEAM(2);
    if (IN(3)) { MKFRAME(); phase_mla_norm(PL, F); } SEAM(3);
    if (IN(4)) { MKFRAME();
        { pg8::Gemm g{(const bf16_t*)(ws + WS_CQ), (const bf16_t*)(ws + WS_WUQ), TROWS, NQ, 512, 512}; pg8::StaticOrder S; S.init(TROWS, NQ, F.G, (int)blockIdx.x);
          EpiQ E{(bf16_t*)(ws + WS_Q), (const f32x2*)(ws + WS_ROPE)};
          pg8::gemm_phase<EpiQ, pg8::StaticOrder, false>(lds, g, S, E, nullptr, F.tid); }
        { pg8::Gemm g{(const bf16_t*)(ws + WS_CKV), (const bf16_t*)(ws + WS_WUKV), TROWS, NKV, 512, 512}; pg8::StaticOrder S; S.init(TROWS, NKV, F.G, (int)blockIdx.x);
          pg8::EpiBf16<0> E{(bf16_t*)(ws + WS_KV), 256, nullptr, 256, (size_t)TROWS * 256};
          pg8::gemm_phase<pg8::EpiBf16<0>, pg8::StaticOrder, false>(lds, g, S, E, nullptr, F.tid); }
    } SEAM(4);
    if (IN(5)) { MKFRAME(); phase_mla_attn(PL, F, lds_raw); if (DBL(5)) { GRID_BAR(); phase_mla_attn<PRB_VAR>(PL, F, lds_raw); } } SEAM(5);
    if (IN(6)) { MKFRAME();
        { pg8::Gemm g{(const bf16_t*)(ws + WS_H), (const bf16_t*)(ws + WS_WO0), TROWS, DM, DM, DM}; LatentOrder S; S.init(NBATCH * SEQ, DM, F.G, (int)blockIdx.x);
          EpiRes E{PL.x, PL.ctx, PL.out, XC, MOD + 2 * DM};
          pg8::gemm_phase<EpiRes, LatentOrder, false>(lds, g, S, E, nullptr, F.tid); }
        { pg8::Gemm g{(const bf16_t*)(ws + WS_H), (const bf16_t*)(ws + WS_WO0), TROWS, DM, DM / NSPLIT, DM}; CtxSplitOrder S; S.init(DM, DM, F.G, (int)blockIdx.x);
          EpiSlab E{(float*)(ws + WS_Q), S.kbytes};
          pg8::gemm_phase<EpiSlab, CtxSplitOrder, false>(lds, g, S, E, nullptr, F.tid); }
    } SEAM(6);
    if (IN(7)) { MKFRAME(); phase_norm<false, true>(PL, F, 0, 1, false, PL.ctx, MOD + 4 * 6 * DM + 2 * DM); } SEAM(7);
    if (IN(8)) { MKFRAME();
        pg8::Gemm g{(const bf16_t*)(ws + WS_H), (const bf16_t*)(ws + WS_WGU0), TROWS, NGU, DM, DM}; pg8::StaticOrder S; S.init(TROWS, NGU, F.G, (int)blockIdx.x);
        EpiSwiglu E{(bf16_t*)(ws + WS_ACT)};
        pg8::gemm_phase<EpiSwiglu, pg8::StaticOrder, false>(lds, g, S, E, nullptr, F.tid);
    } SEAM(8);
    if (IN(9)) { MKFRAME();
        { pg8::Gemm g{(const bf16_t*)(ws + WS_ACT), (const bf16_t*)(ws + WS_WD0), TROWS, DM, DFF, DFF}; LatentOrder S; S.init(NBATCH * SEQ, DM, F.G, (int)blockIdx.x);
          EpiRes E{PL.out, XC, PL.out, XC, MOD + 5 * DM};
          pg8::gemm_phase<EpiRes, LatentOrder, false>(lds, g, S, E, nullptr, F.tid); }
        { pg8::Gemm g{(const bf16_t*)(ws + WS_ACT), (const bf16_t*)(ws + WS_WD0), TROWS, DM, DFF / NSPLIT, DFF}; CtxSplitOrder S; S.init(DM, DFF, F.G, (int)blockIdx.x);
          EpiSlab E{(float*)(ws + WS_Q), S.kbytes};
          pg8::gemm_phase<EpiSlab, CtxSplitOrder, false>(lds, g, S, E, nullptr, F.tid); }
    } SEAM(9);
    if (IN(10)) { MKFRAME(); phase_norm<false, true>(PL, F, 1, 0, false, XC, MOD + 4 * 6 * DM + 5 * DM); } SEAM(10);
    if (IN(11)) { MKFRAME();
        pg8::Gemm g{(const bf16_t*)(ws + WS_H), (const bf16_t*)(ws + WS_WQKV), TROWS, NQKV, DM, DM}; QkvOrder S; S.init(NBATCH * SEQ, NQKV, F.G, (int)blockIdx.x);
        EpiHeads128 E{(bf16_t*)(ws + WS_Q)};
        pg8::gemm_phase<EpiHeads128, QkvOrder, false>(lds, g, S, E, nullptr, F.tid);
    } SEAM(11);
    if (IN(12)) { MKFRAME(); phase_na_attn(PL, F, lds_raw); if (DBL(12)) { GRID_BAR(); phase_na_attn(PL, F, lds_raw); } } SEAM(12);
    if (IN(13)) { MKFRAME();
        pg8::Gemm g{(const bf16_t*)(ws + WS_H), (const bf16_t*)(ws + WS_WO1), TROWS, DM, DM, DM}; LatentOrder S; S.init(NBATCH * SEQ, DM, F.G, (int)blockIdx.x);
        EpiRes E{PL.out, XC, PL.out, XC, MOD + 5 * 6 * DM + 2 * DM};
        pg8::gemm_phase<EpiRes, LatentOrder, false>(lds, g, S, E, nullptr, F.tid);
    } SEAM(13);
    if (IN(14)) { MKFRAME(); phase_norm<false>(PL, F, 1, 1, true); } SEAM(14);
    if (IN(15)) { MKFRAME();
        pg8::Gemm g{(const bf16_t*)(ws + WS_H), (const bf16_t*)(ws + WS_WGU1), TROWS, NGU, DM, DM}; LatentOrder S; S.init(NBATCH * SEQ, NGU, F.G, (int)blockIdx.x);
        EpiSwiglu E{(bf16_t*)(ws + WS_ACT)};
        pg8::gemm_phase<EpiSwiglu, LatentOrder, false>(lds, g, S, E, nullptr, F.tid);
    } SEAM(15);
    if (IN(16)) { MKFRAME();
        pg8::Gemm g{(const bf16_t*)(ws + WS_ACT), (const bf16_t*)(ws + WS_WD1), TROWS, DM, DFF, DFF}; LatentOrder S; S.init(NBATCH * SEQ, DM, F.G, (int)blockIdx.x);
        EpiRes E{PL.out, XC, PL.out, XC, MOD + 5 * 6 * DM + 5 * DM};
        pg8::gemm_phase<EpiRes, LatentOrder, false>(lds, g, S, E, nullptr, F.tid);
    } SEAM(16);
    if (IN(17)) { MKFRAME(); phase_final(PL, F); }
#undef IN
#undef SEAM
}

extern "C" void kernel_launch(void* const* d_in, const int* in_sizes, int n_in, void* d_out, int out_size, void* d_ws, size_t ws_size, hipStream_t stream) {
    static int grid = 0;
    if (grid == 0) {
        if (n_in != 22 || in_sizes[0] != NBATCH * SEQ * DM || out_size != NBATCH * SEQ * DM || ws_size < WS_END + (DBL_MASK ? (size_t)TROWS * DM * 2 : 0)) {
            fprintf(stderr, "kernel_launch: shape/workspace mismatch: n_in %d in0 %d out %d ws %zu (need %zu)\n", n_in, n_in > 0 ? in_sizes[0] : -1, out_size, ws_size, (size_t)WS_END); grid = -1; return; }
        int dev = 0, cus = 0, per_cu = 0;
        hipGetDevice(&dev); hipDeviceGetAttribute(&cus, hipDeviceAttributeMultiprocessorCount, dev);
        if (hipFuncSetAttribute((const void*)mega_fwd, hipFuncAttributeMaxDynamicSharedMemorySize, LDS_BYTES) != hipSuccess) { fprintf(stderr, "kernel_launch: hipFuncSetAttribute failed\n"); grid = -1; return; }
        if (hipOccupancyMaxActiveBlocksPerMultiprocessor(&per_cu, (const void*)mega_fwd, NTHREADS, LDS_BYTES) != hipSuccess || per_cu < 1) { fprintf(stderr, "kernel_launch: occupancy query says %d\n", per_cu); per_cu = 1; }
        (void)hipGetLastError();
        grid = cus * 1;
        fprintf(stderr, "kernel_launch: grid %d (cus %d, per_cu %d)\n", grid, cus, per_cu);
    }
    if (grid < 0) return;
    Params p{};
    const float* const* in = (const float* const*)d_in;
    p.x = in[0]; p.c = in[1]; p.ctx = in[2]; p.c_ctx = in[3]; p.ada_w = in[4]; p.ada_b = in[5]; p.norm_mix = in[6]; p.norm_ffn = in[7]; p.norm_final = in[8];
    p.w_dq = in[9]; p.q_norm = in[10]; p.w_uq = in[11]; p.w_dkv = in[12]; p.kv_norm = in[13]; p.w_ukv = in[14]; p.mla_wo = in[15];
    p.na_wqkv = in[16]; p.na_bias = in[17]; p.na_wo = in[18]; p.w_gate = in[19]; p.w_up = in[20]; p.w_down = in[21];
    p.out = (float*)d_out; p.ws = (unsigned char*)d_ws;
#if MK_ONE_LAUNCH
    p.ph_lo = 0; p.ph_hi = NPHASES;
    void* args[] = {&p};
    hipError_t e = hipLaunchCooperativeKernel((const void*)mega_fwd, dim3(grid), dim3(NTHREADS), args, LDS_BYTES, stream);
    if (e != hipSuccess) fprintf(stderr, "cooperative launch failed: %s (grid %d)\n", hipGetErrorString(e), grid);
#else
    for (int k = 0; k < NPHASES; ++k) { p.ph_lo = k; p.ph_hi = k + 1; hipLaunchKernelGGL(mega_fwd, dim3(grid), dim3(NTHREADS), LDS_BYTES, stream, p); }
#endif
}
```
